# Optimizing an MI355X kernel written in HIP

```python
import jax, jax.numpy as jnp
from jax import lax
import numpy as np

D_MODEL = 1024
BATCH = 8
SEQ = 2048
DEPTH = 4
DEC_BATCH = 128
DEC_SEQ = 1
PAST_LEN = 16384
PAGE_SIZE = 128

D_RNN = D_MODEL
RG_BLOCKS = 16
RG_BW = D_RNN // RG_BLOCKS
RG_CONV = 4
RG_C = 8.0
GLA_HEADS = 4
GLA_DK = D_MODEL // (2 * GLA_HEADS)
GLA_DV = D_MODEL // GLA_HEADS
QK_DIM = GLA_HEADS * GLA_DK
V_DIM = GLA_HEADS * GLA_DV
GLA_RANK = 16
GLA_TAU = 16.0
GLA_CHUNK = 64
D_FF = 3 * D_MODEL
FFN_CONV = 3
N_META = 16
EPS = 1e-6
IN_SIZES = (D_RNN, D_RNN, QK_DIM, QK_DIM, V_DIM, GLA_RANK, V_DIM, D_MODEL, D_MODEL)
D_IN = sum(IN_SIZES)

kernel_name = "hawk_gla_parallel_convffn_step"


def _rmsnorm(x, g):
    xf = x.astype(jnp.float32)
    y = xf * lax.rsqrt(jnp.mean(xf * xf, axis=-1, keepdims=True) + EPS)
    return (y * g.astype(jnp.float32)).astype(x.dtype)


def _causal_dwconv(x, buf, w, b):
    K = w.shape[0]
    T = x.shape[1]
    xx = jnp.concatenate([buf.astype(x.dtype), x], axis=1)
    y = b + xx[:, 0:T] * w[0]
    for j in range(1, K):
        y = y + xx[:, j:j + T] * w[j]
    return y, xx[:, xx.shape[1] - (K - 1):]


def _lin_comb(left, right):
    a1, b1 = left
    a2, b2 = right
    return a1 * a2, a2 * b1 + b2


def _rglru(x, h0, wa, ba, wx, bx, lam):
    B, T, _ = x.shape
    f32 = jnp.float32
    xf = x.astype(f32)
    xb = xf.reshape(B, T, RG_BLOCKS, RG_BW)
    r = jax.nn.sigmoid(jnp.einsum('btnc,ncd->btnd', xb, wa.astype(f32)).reshape(B, T, D_RNN) + ba.astype(f32))
    i = jax.nn.sigmoid(jnp.einsum('btnc,ncd->btnd', xb, wx.astype(f32)).reshape(B, T, D_RNN) + bx.astype(f32))
    log_a = -RG_C * r * jax.nn.softplus(-lam.astype(f32))
    a = jnp.exp(log_a)
    b = jnp.sqrt(-jnp.expm1(2.0 * log_a)) * (i * xf)
    b = b.at[:, 0].add(a[:, 0] * h0.astype(f32))
    _, h = lax.associative_scan(_lin_comb, (a, b), axis=1)
    return h.astype(x.dtype), h[:, -1].astype(x.dtype)


def _gla(q, k, v, log_alpha, S0, pad_left):
    f32 = jnp.float32
    B, T, H, DK = q.shape
    DV = v.shape[-1]
    C = GLA_CHUNK
    pad_right = (-(pad_left + T)) % C
    pw = ((0, 0), (pad_left, pad_right), (0, 0), (0, 0))
    q, k, v, g = [jnp.pad(t.astype(f32), pw) for t in (q, k, v, log_alpha)]
    Tp = T + pad_left + pad_right
    n = Tp // C

    def blk(t):
        return t.reshape(B, n, C, H, t.shape[-1]).transpose(0, 3, 1, 2, 4)

    q, k, v, g = blk(q), blk(k), blk(v), blk(g)
    bc = jnp.cumsum(g, axis=3)
    bl = bc[:, :, :, -1:]
    qd = q * jnp.exp(bc)
    kd = k * jnp.exp(-bc)
    ke = k * jnp.exp(bl - bc)
    mask = jnp.tril(jnp.ones((C, C), dtype=bool))
    A = jnp.where(mask, jnp.einsum('bhncd,bhnsd->bhncs', qd, kd), 0.0)
    o = jnp.einsum('bhncs,bhnse->bhnce', A, v)
    dS = jnp.einsum('bhncd,bhnce->bhnde', ke, v)
    decay = jnp.exp(bl[:, :, :, 0])

    def step(S, inp):
        dec, ds = inp
        return dec[..., None] * S + ds, S

    S_T, S_starts = lax.scan(step, S0.astype(f32), (jnp.moveaxis(decay, 2, 0), jnp.moveaxis(dS, 2, 0)))
    o = o + jnp.einsum('bhncd,nbhde->bhnce', qd, S_starts)
    o = o.transpose(0, 2, 3, 1, 4).reshape(B, Tp, H, DV)[:, pad_left:pad_left + T]
    return o, S_T


def _layer(x, rg_buf, h0, S0, ffn_buf, pad_left, p):
    B, T, _ = x.shape
    f32 = jnp.float32
    xn = _rmsnorm(x, p['norm1_g'])
    z = jnp.einsum('btd,de->bte', xn, p['w_in'])
    split_points = [int(s) for s in np.cumsum(IN_SIZES)[:-1]]
    rg_x, rg_y, q, k, v, g_lr, g_out, m_a, m_b = jnp.split(z, split_points, axis=-1)
    xc, new_rg_buf = _causal_dwconv(rg_x, rg_buf, p['rg_conv_w'], p['rg_conv_b'])
    h, hT = _rglru(xc, h0, p['rg_wa'], p['rg_ba'], p['rg_wx'], p['rg_bx'], p['rg_lambda'])
    ya = jnp.einsum('btc,cd->btd', h * jax.nn.gelu(rg_y), p['w_branch_a'])
    zg = jnp.einsum('btr,rk->btk', g_lr, p['gla_w_gate']) + p['gla_b_gate']
    log_alpha = (jax.nn.log_sigmoid(zg.astype(f32)) / GLA_TAU).reshape(B, T, GLA_HEADS, GLA_DK)
    qh = q.reshape(B, T, GLA_HEADS, GLA_DK) * (GLA_DK ** -0.5)
    kh = k.reshape(B, T, GLA_HEADS, GLA_DK)
    vh = v.reshape(B, T, GLA_HEADS, GLA_DV)
    o, S_T = _gla(qh, kh, vh, log_alpha, S0, pad_left)
    o = o * lax.rsqrt(jnp.mean(o * o, axis=-1, keepdims=True) + EPS) * p['gla_norm_g'].astype(f32)
    o = o * jax.nn.silu(g_out.reshape(B, T, GLA_HEADS, GLA_DV).astype(f32))
    yb = jnp.einsum('btc,cd->btd', o.astype(x.dtype).reshape(B, T, V_DIM), p['w_branch_b'])
    merged = jax.nn.sigmoid(m_a) * ya + jax.nn.sigmoid(m_b) * yb
    x = x + jnp.einsum('btd,de->bte', merged, p['w_out'])
    xn2 = _rmsnorm(x, p['norm2_g'])
    u = jnp.einsum('btd,df->btf', xn2, p['w_ffn_up'])
    uc, new_ffn_buf = _causal_dwconv(u, ffn_buf, p['ffn_conv_w'], p['ffn_conv_b'])
    gate, val = jnp.split(uc, 2, axis=-1)
    x = x + jnp.einsum('btf,fd->btd', jax.nn.gelu(gate) * val, p['w_ffn_down'])
    return x, new_rg_buf, hT, S_T.astype(x.dtype), new_ffn_buf


def _trunk(x, rg_buf, rg_h, gla_S, ffn_buf, pad_left, p, final_norm_g):
    bufs, hs, Ss, fbufs = [], [], [], []
    for l in range(DEPTH):
        pl = {name: arr[l] for name, arr in p.items()}
        x, nb, nh, nS, nf = _layer(x, rg_buf[l], rg_h[l], gla_S[l], ffn_buf[l], pad_left, pl)
        bufs.append(nb)
        hs.append(nh)
        Ss.append(nS)
        fbufs.append(nf)
    y = _rmsnorm(x, final_norm_g)
    return y, jnp.stack(bufs), jnp.stack(hs), jnp.stack(Ss), jnp.stack(fbufs)


def setup_inputs(seed: int = 0) -> dict:
    key = jax.random.key(seed)
    ks = jax.random.split(key, 32)
    f32 = jnp.float32

    def nrm(k, shape, scale):
        return jax.random.normal(k, shape, f32) * scale

    a0 = jax.random.uniform(ks[12], (DEPTH, D_RNN), f32, 0.9, 0.999)
    return {
        "x_prompt": nrm(ks[0], (BATCH, SEQ, D_MODEL), 1.0),
        "x_sample": nrm(ks[1], (DEC_BATCH, DEC_SEQ, D_MODEL), 1.0),
        "state_rg_conv": nrm(ks[2], (DEPTH, DEC_BATCH, RG_CONV - 1, D_RNN), 1.0),
        "state_rg_h": nrm(ks[3], (DEPTH, DEC_BATCH, D_RNN), 0.5),
        "state_gla": nrm(ks[4], (DEPTH, DEC_BATCH, GLA_HEADS, GLA_DK, GLA_DV), 1.0),
        "state_ffn_conv": nrm(ks[5], (DEPTH, DEC_BATCH, FFN_CONV - 1, 2 * D_FF), 1.0),
        "meta_tokens": nrm(ks[6], (N_META, D_MODEL), 1.0),
        "norm1_g": 1.0 + nrm(ks[7], (DEPTH, D_MODEL), 0.02),
        "w_in": nrm(ks[8], (DEPTH, D_MODEL, D_IN), D_MODEL ** -0.5),
        "rg_conv_w": nrm(ks[9], (DEPTH, RG_CONV, D_RNN), RG_CONV ** -0.5),
        "rg_conv_b": nrm(ks[10], (DEPTH, D_RNN), 0.02),
        "rg_wa": nrm(ks[11], (DEPTH, RG_BLOCKS, RG_BW, RG_BW), RG_BW ** -0.5),
        "rg_ba": nrm(ks[13], (DEPTH, D_RNN), 0.02),
        "rg_wx": nrm(ks[14], (DEPTH, RG_BLOCKS, RG_BW, RG_BW), RG_BW ** -0.5),
        "rg_bx": nrm(ks[15], (DEPTH, D_RNN), 0.02),
        "rg_lambda": jnp.log(a0 / (1.0 - a0)),
        "gla_w_gate": nrm(ks[16], (DEPTH, GLA_RANK, QK_DIM), GLA_RANK ** -0.5),
        "gla_b_gate": nrm(ks[17], (DEPTH, QK_DIM), 0.1),
        "gla_norm_g": 1.0 + nrm(ks[18], (DEPTH, GLA_HEADS, GLA_DV), 0.02),
        "w_branch_a": nrm(ks[19], (DEPTH, D_RNN, D_MODEL), D_RNN ** -0.5),
        "w_branch_b": nrm(ks[20], (DEPTH, V_DIM, D_MODEL), V_DIM ** -0.5),
        "w_out": nrm(ks[21], (DEPTH, D_MODEL, D_MODEL), D_MODEL ** -0.5),
        "norm2_g": 1.0 + nrm(ks[22], (DEPTH, D_MODEL), 0.02),
        "w_ffn_up": nrm(ks[23], (DEPTH, D_MODEL, 2 * D_FF), D_MODEL ** -0.5),
        "ffn_conv_w": nrm(ks[24], (DEPTH, FFN_CONV, 2 * D_FF), FFN_CONV ** -0.5),
        "ffn_conv_b": nrm(ks[25], (DEPTH, 2 * D_FF), 0.02),
        "w_ffn_down": nrm(ks[26], (DEPTH, D_FF, D_MODEL), D_FF ** -0.5),
        "final_norm_g": 1.0 + nrm(ks[27], (D_MODEL,), 0.02),
    }


def reference(x_prompt, x_sample, state_rg_conv, state_rg_h, state_gla, state_ffn_conv,
              meta_tokens, norm1_g, w_in, rg_conv_w, rg_conv_b, rg_wa, rg_ba, rg_wx, rg_bx,
              rg_lambda, gla_w_gate, gla_b_gate, gla_norm_g, w_branch_a, w_branch_b, w_out,
              norm2_g, w_ffn_up, ffn_conv_w, ffn_conv_b, w_ffn_down, final_norm_g):
    p = dict(norm1_g=norm1_g, w_in=w_in, rg_conv_w=rg_conv_w, rg_conv_b=rg_conv_b,
             rg_wa=rg_wa, rg_ba=rg_ba, rg_wx=rg_wx, rg_bx=rg_bx, rg_lambda=rg_lambda,
             gla_w_gate=gla_w_gate, gla_b_gate=gla_b_gate, gla_norm_g=gla_norm_g,
             w_branch_a=w_branch_a, w_branch_b=w_branch_b, w_out=w_out, norm2_g=norm2_g,
             w_ffn_up=w_ffn_up, ffn_conv_w=ffn_conv_w, ffn_conv_b=ffn_conv_b,
             w_ffn_down=w_ffn_down)
    dt = x_prompt.dtype
    B = x_prompt.shape[0]
    xp = jnp.concatenate([jnp.broadcast_to(meta_tokens.astype(dt)[None], (B, N_META, D_MODEL)), x_prompt], axis=1)
    zeros_rg_buf = jnp.zeros((DEPTH, B, RG_CONV - 1, D_RNN), dt)
    zeros_h = jnp.zeros((DEPTH, B, D_RNN), dt)
    zeros_S = jnp.zeros((DEPTH, B, GLA_HEADS, GLA_DK, GLA_DV), dt)
    zeros_ffn = jnp.zeros((DEPTH, B, FFN_CONV - 1, 2 * D_FF), dt)
    meta_pad = (-N_META) % GLA_CHUNK
    yp, rg_conv_prompt, rg_h_prompt, gla_prompt, ffn_conv_prompt = _trunk(
        xp, zeros_rg_buf, zeros_h, zeros_S, zeros_ffn, meta_pad, p, final_norm_g)
    y_prompt = yp[:, N_META:]
    y_sample, rg_conv_sample, rg_h_sample, gla_sample, ffn_conv_sample = _trunk(
        x_sample, state_rg_conv, state_rg_h, state_gla, state_ffn_conv, 0, p, final_norm_g)
    return (y_prompt, y_sample, rg_conv_prompt, rg_h_prompt, gla_prompt, ffn_conv_prompt,
            rg_conv_sample, rg_h_sample, gla_sample, ffn_conv_sample)
```

```cpp
#include <hip/hip_runtime.h>
#include <hip/hip_cooperative_groups.h>
#include <cstdio>
#include <cstdint>
namespace cg = cooperative_groups;

#define LAS __attribute__((address_space(3)))
typedef unsigned short bf16_t;
typedef short bf16x8 __attribute__((ext_vector_type(8)));
typedef float f32x4 __attribute__((ext_vector_type(4)));
typedef float f32x2 __attribute__((ext_vector_type(2)));
typedef unsigned u32x4 __attribute__((ext_vector_type(4)));
typedef unsigned u32x2 __attribute__((ext_vector_type(2)));
typedef __bf16 bf16x2_t __attribute__((ext_vector_type(2)));

constexpr int D = 1024, NB = 8, TP = 2064, DEPTH = 4, NS = 128, NCH = 33;
constexpr int MP = NB * TP;
constexpr int M = MP + NS;
constexpr int MM = 16384;
constexpr int NZ = 7424;
constexpr int DFF = 3072, DUP = 6144;
constexpr int ZC_RGX = 0, ZC_RGY = 1024, ZC_Q = 2048, ZC_K = 2560, ZC_V = 3072, ZC_GOUT = 4096, ZC_MA = 5120, ZC_MB = 6144, ZC_GLR = 7168;
constexpr float EPS = 1e-6f;

constexpr size_t O_YP = 0, O_YS = 16777216, O_RCP = O_YS + 131072, O_RHP = O_RCP + 98304, O_GP = O_RHP + 32768, O_FCP = O_GP + 4194304,
                 O_RCS = O_FCP + 393216, O_RHS = O_RCS + 1572864, O_GS = O_RHS + 524288, O_FCS = O_GS + 67108864;

constexpr size_t al256(size_t x) { return (x + 255) & ~(size_t)255; }
constexpr size_t WS_WIN = 0;
constexpr size_t WS_WA = WS_WIN + (size_t)DEPTH * NZ * D * 2;
constexpr size_t WS_WB = WS_WA + (size_t)DEPTH * D * D * 2;
constexpr size_t WS_WO = WS_WB + (size_t)DEPTH * D * D * 2;
constexpr size_t WS_WUP = WS_WO + (size_t)DEPTH * D * D * 2;
constexpr size_t WS_WDN = WS_WUP + (size_t)DEPTH * DUP * D * 2;
constexpr size_t WS_RGW = WS_WDN + (size_t)DEPTH * D * DFF * 2;
constexpr size_t WS_XF = WS_RGW + (size_t)DEPTH * 2 * 16 * 64 * 64 * 2;
constexpr size_t WS_XB = WS_XF + (size_t)M * D * 4;
constexpr size_t WS_Z = WS_XB + (size_t)M * D * 2;
constexpr size_t WS_U = WS_Z;
constexpr size_t WS_HG = WS_Z + (size_t)M * NZ * 2;
constexpr size_t WS_OG = WS_HG + (size_t)M * D * 2;
constexpr size_t WS_MG = WS_OG + (size_t)M * D * 2;
constexpr size_t WS_ACT = WS_HG;
constexpr size_t WS_T = WS_MG + (size_t)M * D * 2;
constexpr size_t WS_QD = WS_T + (size_t)M * D * 4;
constexpr size_t CHT = (size_t)NB * NCH * 4 * 64 * 128;
constexpr size_t WS_KD = WS_QD + CHT * 2;
constexpr size_t WS_KET = WS_KD + CHT * 2;
constexpr size_t WS_VT = WS_KET + CHT * 2;
constexpr size_t WS_DEC = WS_VT + CHT * 4;
constexpr size_t WS_CARRY = WS_DEC + (size_t)NB * NCH * 512 * 4;
constexpr size_t WS_SS = WS_CARRY + (size_t)NB * NCH * 1024 * 2 * 4;
constexpr size_t WS_GSS = al256(WS_SS + (size_t)2 * M * 16 * 4);
constexpr size_t WS_BAR = al256(WS_GSS + (size_t)MP * 4 * 16 * 4);
constexpr size_t WS_END = al256(WS_BAR + 16384);
static_assert(WS_END < 1000000000ull, "workspace map");

constexpr int LDS_BYTES = 163840;

struct Params { const float* in[28]; float* out; unsigned char* ws; int ph_lo, ph_hi; };
constexpr int PTAB_OFF = 163328;
struct Ctx { LAS const unsigned long long* pt; float* out; unsigned char* ws; };
__device__ __forceinline__ const float* INP(const Ctx& X, int i) { const unsigned long long v = X.pt[i];
    const unsigned lo = __builtin_amdgcn_readfirstlane((unsigned)v), hi = __builtin_amdgcn_readfirstlane((unsigned)(v >> 32)); return (const float*)(((unsigned long long)hi << 32) | lo); }

__device__ __forceinline__ float bf2f(unsigned b) { return __uint_as_float(b << 16); }
__device__ __forceinline__ float bflo(unsigned w) { return __uint_as_float(w << 16); }
__device__ __forceinline__ float bfhi(unsigned w) { return __uint_as_float(w & 0xffff0000u); }
__device__ __forceinline__ unsigned pk2(float lo, float hi) { f32x2 v = {lo, hi}; bf16x2_t b = __builtin_convertvector(v, bf16x2_t); return __builtin_bit_cast(unsigned, b); }
__device__ __forceinline__ bf16_t f2bf(float f) { return (bf16_t)(pk2(f, 0.f) & 0xffffu); }
__device__ __forceinline__ float ss_total(const float* ss, int row) { const f32x4* sp = (const f32x4*)(ss + (size_t)row * 16); const f32x4 a = sp[0], b = sp[1], c = sp[2], d = sp[3];
    return (((a[0] + a[1]) + (a[2] + a[3])) + ((b[0] + b[1]) + (b[2] + b[3]))) + (((c[0] + c[1]) + (c[2] + c[3])) + ((d[0] + d[1]) + (d[2] + d[3]))); }
__device__ __forceinline__ float sigm(float x) { return __builtin_amdgcn_rcpf(1.f + __expf(-x)); }
__device__ __forceinline__ float softplus_(float x) { return fmaxf(x, 0.f) + __logf(1.f + __expf(-fabsf(x))); }
__device__ __forceinline__ float gelu_t(float x) { const float u = 0.7978845608028654f * (x + 0.044715f * x * x * x); return x * sigm(2.f * u); }
__device__ __forceinline__ float silu_(float x) { return x * sigm(x); }
__device__ __forceinline__ int opaque_tid() { int t = threadIdx.x; asm volatile("" : "+v"(t)); return t; }
__device__ __forceinline__ int opaque_bid() { int b = blockIdx.x; asm volatile("" : "+s"(b)); return b; }
__device__ __forceinline__ unsigned char* opaque_ptr(unsigned char* p) { asm volatile("" : "+s"(p)); return p; }
#define WAVE_LDS_FENCE() asm volatile("s_waitcnt lgkmcnt(0)" ::: "memory")
#define MFMA16(a, b, c) __builtin_amdgcn_mfma_f32_16x16x32_bf16((a), (b), (c), 0, 0, 0)

namespace pg8 {
constexpr int BM = 256, BK = 64, HALF = 128, HTB = HALF * BK * 2, STAGE_BYTES = 8 * HTB, NXCD = 8, WGM = 8;
__host__ __device__ __forceinline__ int lds_byte(int r, int c) { const int st = (r >> 4) * 2 + (c >> 5), rr = r & 15, cc = c & 31, ob = rr * 64 + cc * 2; return st * 1024 + (ob ^ (((ob >> 9) & 1) << 5)); }
__host__ __device__ __forceinline__ void stage_rc(int b, int& R, int& C) { const int st = b / 1024, sb = b % 1024, swz = sb ^ (((sb >> 9) & 1) << 5); R = (st >> 1) * 16 + swz / 64; C = (st & 1) * 32 + (swz % 64) / 2; }
__host__ __device__ __forceinline__ int perm32(int rho) { const int n = rho >> 4, i = rho & 15; return 8 * (i >> 2) + 4 * n + (i & 3); }
struct Unit { int pm, pn; };
struct Gemm { const bf16_t* A; const bf16_t* Bt; int M, N, K; };
struct StaticOrder {
    int nM, nN, nwg, G, c;
    __device__ void init(int M_, int N_, int G_, int c_) { nM = M_ / BM; nN = N_ / BM; nwg = nM * nN; G = G_; c = c_; }
    __device__ bool next(int i, Unit& u) const {
        const long L = (long)i * G + c; if (L >= nwg) return false;
        int wgid = (int)L; { const int q = nwg / NXCD, r = nwg % NXCD, xcd = wgid % NXCD, off = wgid / NXCD; wgid = (xcd < r ? xcd * (q + 1) : r * (q + 1) + (xcd - r) * q) + off; }
        const int nig = WGM * nN, gid = wgid / nig, fm = gid * WGM, gsz = (nM - fm) < WGM ? (nM - fm) : WGM;
        u.pm = fm + ((wgid % nig) % gsz); u.pn = (wgid % nig) / gsz; return true;
    }
};
template <class Epi>
__device__ __forceinline__ void gemm_phase(LAS unsigned char* lds, const Gemm g, const StaticOrder& S, const Epi& E) {
    const int tid = opaque_tid(), wid = __builtin_amdgcn_readfirstlane(tid >> 6), lane = tid & 63, wr = wid >> 2, wc = wid & 3, fr = lane & 15, fq = lane >> 4;
    const int K = g.K, nt = K / BK;
    unsigned voffA[2], voffB[2];
#pragma unroll
    for (int i = 0; i < 2; ++i) { int R, C; stage_rc(tid * 16 + i * 8192, R, C); const int Rb = Epi::PERM ? ((R & ~31) + perm32(R & 31)) : R;
        voffA[i] = (unsigned)(R * K + C) * 2u; voffB[i] = (unsigned)(Rb * K + C) * 2u; }
    const size_t kstep = (size_t)(BK * 2);
    const size_t hstep = (size_t)HALF * K * 2;
    const size_t tstep = 2 * hstep;
    const unsigned ldsw = (unsigned)wid * 1024u;
    const int aoff = lds_byte(wr * 64 + fr, fq * 8), boff = lds_byte(wc * 32 + fr, fq * 8);
#define PG8_SA(b, h) (((b) * 2 + (h)) * HTB)
#define PG8_SB(b, h) ((4 + (b) * 2 + (h)) * HTB)
#define PG8_STAGE(bufoff, gbase, voff) do { _Pragma("unroll") for (int _i = 0; _i < 2; ++_i) \
        __builtin_amdgcn_global_load_lds((const unsigned*)((const char*)(gbase) + (voff)[_i]), (LAS unsigned*)(lds + (bufoff) + ldsw + _i * 8192), 16, 0, 0); } while (0)
#define PG8_LDA(dst, b, h) do { _Pragma("unroll") for (int m = 0; m < 4; ++m) _Pragma("unroll") for (int k = 0; k < 2; ++k) dst[m][k] = *(const LAS bf16x8*)(lds + PG8_SA(b, h) + aoff + m * 2048 + k * 1024); } while (0)
#define PG8_LDB(dst, b, h) do { _Pragma("unroll") for (int n = 0; n < 2; ++n) _Pragma("unroll") for (int k = 0; k < 2; ++k) dst[n][k] = *(const LAS bf16x8*)(lds + PG8_SB(b, h) + boff + n * 2048 + k * 1024); } while (0)
#define PG8_MMA(ai, bj, At, Bt) do { __builtin_amdgcn_s_setprio(1); _Pragma("unroll") for (int m = 0; m < 4; ++m) _Pragma("unroll") for (int n = 0; n < 2; ++n) _Pragma("unroll") for (int k = 0; k < 2; ++k) \
        acc[ai][bj][m][n] = __builtin_amdgcn_mfma_f32_16x16x32_bf16(Bt[n][k], At[m][k], acc[ai][bj][m][n], 0, 0, 0); __builtin_amdgcn_s_setprio(0); } while (0)
#define PG8_WAIT_V(n) asm volatile("s_waitcnt vmcnt(" #n ")" ::: "memory")
#define PG8_WAIT_L(n) asm volatile("s_waitcnt lgkmcnt(" #n ")" ::: "memory")
#define PG8_BAR __builtin_amdgcn_s_barrier()
#define PG8_SCHED __builtin_amdgcn_sched_barrier(0)
    Unit cur, nxt; int ui = 0;
    if (!S.next(0, cur)) return;
    f32x4 acc[2][2][4][2];
#pragma unroll
    for (int a = 0; a < 2; ++a)
#pragma unroll
        for (int b = 0; b < 2; ++b)
#pragma unroll
            for (int m = 0; m < 4; ++m)
#pragma unroll
                for (int n = 0; n < 2; ++n) acc[a][b][m][n] = (f32x4){0.f, 0.f, 0.f, 0.f};
    bf16x8 At[4][2], B0[2][2], B1[2][2];
    const char* cA = (const char*)g.A + (size_t)cur.pm * tstep; const char* cB = (const char*)g.Bt + (size_t)cur.pn * tstep;
    PG8_STAGE(PG8_SB(0, 0), cB, voffB); PG8_STAGE(PG8_SB(0, 1), cB + hstep, voffB); PG8_STAGE(PG8_SA(0, 0), cA, voffA); PG8_STAGE(PG8_SA(0, 1), cA + hstep, voffA);
    if (wr == 1) PG8_BAR;
    PG8_WAIT_V(2); PG8_BAR;
    PG8_STAGE(PG8_SB(1, 0), cB + kstep, voffB); PG8_STAGE(PG8_SA(1, 0), cA + kstep, voffA); PG8_STAGE(PG8_SB(1, 1), cB + hstep + kstep, voffB);
    PG8_WAIT_V(6); PG8_BAR;
    for (;;) {
        const bool has_next = S.next(ui + 1, nxt);
        const char* nA = has_next ? (const char*)g.A + (size_t)nxt.pm * tstep : cA; const char* nB = has_next ? (const char*)g.Bt + (size_t)nxt.pn * tstep : cB;
        for (int t = 0; t < nt; t += 2) {
            const bool last = (t == nt - 2);
            const char* a1 = cA + (size_t)(t + 1) * kstep;
            const char* a2 = last ? nA : cA + (size_t)(t + 2) * kstep; const char* b2 = last ? nB : cB + (size_t)(t + 2) * kstep;
            const char* a3 = a2 + kstep; const char* b3 = b2 + kstep;
            PG8_LDB(B0, 0, 0); PG8_LDB(B1, 0, 1); PG8_SCHED; PG8_LDA(At, 0, 0); PG8_STAGE(PG8_SA(1, 1), a1 + hstep, voffA);
            PG8_WAIT_V(8); PG8_WAIT_L(0); PG8_BAR; PG8_MMA(0, 0, At, B0); PG8_MMA(0, 1, At, B1); PG8_BAR; PG8_SCHED;
            PG8_LDA(At, 0, 1); PG8_STAGE(PG8_SB(0, 0), b2, voffB); PG8_STAGE(PG8_SB(0, 1), b2 + hstep, voffB); PG8_STAGE(PG8_SA(0, 0), a2, voffA);
            PG8_WAIT_V(8); PG8_WAIT_L(0); PG8_BAR; PG8_MMA(1, 0, At, B0); PG8_MMA(1, 1, At, B1); PG8_BAR; PG8_SCHED;
            PG8_LDB(B0, 1, 0); PG8_LDB(B1, 1, 1); PG8_SCHED; PG8_LDA(At, 1, 0); PG8_STAGE(PG8_SA(0, 1), a2 + hstep, voffA);
            PG8_WAIT_V(8); PG8_WAIT_L(0); PG8_BAR; PG8_MMA(0, 0, At, B0); PG8_MMA(0, 1, At, B1); PG8_BAR; PG8_SCHED;
            PG8_LDA(At, 1, 1); PG8_STAGE(PG8_SB(1, 0), b3, voffB); PG8_STAGE(PG8_SB(1, 1), b3 + hstep, voffB); PG8_STAGE(PG8_SA(1, 0), a3, voffA);
            PG8_WAIT_V(8); PG8_WAIT_L(0); PG8_BAR; PG8_MMA(1, 0, At, B0); PG8_MMA(1, 1, At, B1); PG8_BAR; PG8_SCHED;
        }
        if (wr == 0) PG8_BAR;
        E(acc, cur, wr, wc, fr, fq);
        if (!has_next) break;
#pragma unroll
        for (int a = 0; a < 2; ++a)
#pragma unroll
            for (int b = 0; b < 2; ++b)
#pragma unroll
                for (int m = 0; m < 4; ++m)
#pragma unroll
                    for (int n = 0; n < 2; ++n) acc[a][b][m][n] = (f32x4){0.f, 0.f, 0.f, 0.f};
        cur = nxt; cA = nA; cB = nB; ++ui;
        if (wr == 1) PG8_BAR;
    }
    PG8_WAIT_V(0);
    PG8_BAR;
#undef PG8_SA
#undef PG8_SB
#undef PG8_STAGE
#undef PG8_LDA
#undef PG8_LDB
#undef PG8_MMA
#undef PG8_WAIT_V
#undef PG8_WAIT_L
#undef PG8_BAR
#undef PG8_SCHED
}
}

struct EpiScale {
    static constexpr bool PERM = true;
    bf16_t* O; int ldc; const float* ss;
    __device__ __forceinline__ void operator()(const f32x4 (&acc)[2][2][4][2], const pg8::Unit& u, int wr, int wc, int fr, int fq) const {
        const int row0 = u.pm * 256 + wr * 64 + fr, col0 = u.pn * 256 + wc * 32 + 8 * fq;
#pragma unroll
        for (int ai = 0; ai < 2; ++ai)
#pragma unroll
            for (int m = 0; m < 4; ++m) { const int row = row0 + ai * 128 + m * 16; const float rs = rsqrtf(ss_total(ss, row) * (1.f / 1024.f) + EPS);
                bf16_t* rowp = O + (size_t)row * ldc + col0;
#pragma unroll
                for (int bj = 0; bj < 2; ++bj) { const f32x4 v0 = acc[ai][bj][m][0] * rs, v1 = acc[ai][bj][m][1] * rs;
                    u32x4 w; w.x = pk2(v0[0], v0[1]); w.y = pk2(v0[2], v0[3]); w.z = pk2(v1[0], v1[1]); w.w = pk2(v1[2], v1[3]);
                    *(u32x4*)(rowp + bj * 128) = w; } }
    }
    template <int QPR> __device__ __forceinline__ void tailq(int row, int c, f32x4 v, int) const {
        const float rs = rsqrtf(ss_total(ss, row) * (1.f / 1024.f) + EPS); v = v * rs;
        u32x2 w; w.x = pk2(v[0], v[1]); w.y = pk2(v[2], v[3]); *(u32x2*)(O + (size_t)row * ldc + c) = w; }
};
struct EpiYa {
    static constexpr bool PERM = false;
    bf16_t* T; const bf16_t* Z;
    __device__ __forceinline__ void quad(int row, int c, f32x4 v) const {
        const u32x2 gw = *(const u32x2*)(Z + (size_t)row * NZ + ZC_MA + c);
        v[0] *= sigm(bflo(gw.x)); v[1] *= sigm(bfhi(gw.x)); v[2] *= sigm(bflo(gw.y)); v[3] *= sigm(bfhi(gw.y));
        u32x2 w; w.x = pk2(v[0], v[1]); w.y = pk2(v[2], v[3]); *(u32x2*)(T + (size_t)row * D + c) = w; }
    template <int QPR> __device__ __forceinline__ void tailq(int row, int c, const f32x4 v, int) const { quad(row, c, v); }
    __device__ __forceinline__ void operator()(const f32x4 (&acc)[2][2][4][2], const pg8::Unit& u, int wr, int wc, int fr, int fq) const {
        const int row0 = u.pm * 256 + wr * 64 + fr, col0 = u.pn * 256 + wc * 32 + 4 * fq;
#pragma unroll
        for (int ai = 0; ai < 2; ++ai)
#pragma unroll
            for (int m = 0; m < 4; ++m) { const int row = row0 + ai * 128 + m * 16;
#pragma unroll
                for (int bj = 0; bj < 2; ++bj)
#pragma unroll
                    for (int n = 0; n < 2; ++n) { const int c = col0 + bj * 128 + n * 16;
                        quad(row, c, acc[ai][bj][m][n]); } }
    }
};
struct EpiMerge {
    static constexpr bool PERM = false;
    const bf16_t* T; const bf16_t* Z; bf16_t* MG;
    __device__ __forceinline__ void quad(int row, int c, const f32x4 a) const {
        const u32x2 gw = *(const u32x2*)(Z + (size_t)row * NZ + ZC_MB + c);
        const u32x2 tw = *(const u32x2*)(T + (size_t)row * D + c); const f32x4 t = {bflo(tw.x), bfhi(tw.x), bflo(tw.y), bfhi(tw.y)};
        const float v0 = t[0] + a[0] * sigm(bflo(gw.x)), v1 = t[1] + a[1] * sigm(bfhi(gw.x)), v2 = t[2] + a[2] * sigm(bflo(gw.y)), v3 = t[3] + a[3] * sigm(bfhi(gw.y));
        u32x2 w; w.x = pk2(v0, v1); w.y = pk2(v2, v3);
        *(u32x2*)(MG + (size_t)row * D + c) = w; }
    template <int QPR> __device__ __forceinline__ void tailq(int row, int c, const f32x4 v, int) const { quad(row, c, v); }
    __device__ __forceinline__ void operator()(const f32x4 (&acc)[2][2][4][2], const pg8::Unit& u, int wr, int wc, int fr, int fq) const {
        const int row0 = u.pm * 256 + wr * 64 + fr, col0 = u.pn * 256 + wc * 32 + 4 * fq;
#pragma unroll
        for (int ai = 0; ai < 2; ++ai)
#pragma unroll
            for (int m = 0; m < 4; ++m) { const int row = row0 + ai * 128 + m * 16;
#pragma unroll
                for (int bj = 0; bj < 2; ++bj)
#pragma unroll
                    for (int n = 0; n < 2; ++n) { const int c = col0 + bj * 128 + n * 16;
                        quad(row, c, acc[ai][bj][m][n]); } }
    }
};
struct EpiResid {
    static constexpr bool PERM = false;
    bf16_t* XB; float* ss;
    __device__ __forceinline__ float quad(int row, int c, const f32x4 a) const {
        bf16_t* xp = XB + (size_t)row * D + c;
        const u32x2 xw = *(const u32x2*)xp;
        const f32x4 x = (f32x4){bflo(xw.x), bfhi(xw.x), bflo(xw.y), bfhi(xw.y)} + a;
        u32x2 w; w.x = pk2(x[0], x[1]); w.y = pk2(x[2], x[3]);
        *(u32x2*)xp = w;
        return (x[0] * x[0] + x[1] * x[1]) + (x[2] * x[2] + x[3] * x[3]); }
    template <int QPR> __device__ __forceinline__ void tailq(int row, int c, const f32x4 v, int c0) const {
        float sq = quad(row, c, v);
#pragma unroll
        for (int o = 1; o < QPR; o <<= 1) sq += __shfl_xor(sq, o);
        if ((threadIdx.x & (QPR - 1)) == 0) ss[(size_t)row * 16 + (c0 >> 6)] = sq; }
    __device__ __forceinline__ void operator()(const f32x4 (&acc)[2][2][4][2], const pg8::Unit& u, int wr, int wc, int fr, int fq) const {
        const int row0 = u.pm * 256 + wr * 64 + fr, col0 = u.pn * 256 + wc * 32 + 4 * fq;
#pragma unroll
        for (int ai = 0; ai < 2; ++ai)
#pragma unroll
            for (int m = 0; m < 4; ++m) { const int row = row0 + ai * 128 + m * 16; float sq = 0.f;
#pragma unroll
                for (int bj = 0; bj < 2; ++bj)
#pragma unroll
                    for (int n = 0; n < 2; ++n) { const int c = col0 + bj * 128 + n * 16;
                        sq += quad(row, c, acc[ai][bj][m][n]); }
                sq += __shfl_xor(sq, 16); sq += __shfl_xor(sq, 32);
                if (fq == 0) ss[(size_t)row * 16 + u.pn * 4 + wc] = sq; }
    }
};

template <int MT, int NT, class Epi>
__device__ __forceinline__ void tail_splitk(LAS unsigned char* lds, const bf16_t* A, const bf16_t* Bt, int K, int row_base, int n_rt, int col_base, int n_ct, int it0, const Epi& E) {
    const int tid = opaque_tid(), lane = tid & 63, w = __builtin_amdgcn_readfirstlane(tid >> 6), fr = lane & 15, fq = lane >> 4, bid = opaque_bid(), G = gridDim.x;
    constexpr int RS = NT * 16 + 4, WB = MT * 16 * RS * 4, QPR = NT * 4;
    const int nks = K / 256;
    for (int it = (bid - it0 + G) % G; it < n_rt * n_ct; it += G) {
        const int rt = it % n_rt, ct = it / n_rt, r0 = row_base + rt * 16 * MT, c0 = col_base + ct * 16 * NT;
        f32x4 acc[MT][NT];
#pragma unroll
        for (int mt = 0; mt < MT; ++mt)
#pragma unroll
            for (int nt = 0; nt < NT; ++nt) acc[mt][nt] = (f32x4){0.f, 0.f, 0.f, 0.f};
        const bf16_t* ap = A + (size_t)(r0 + fr) * K + fq * 8 + w * nks * 32; const bf16_t* bp = Bt + (size_t)(c0 + fr) * K + fq * 8 + w * nks * 32;
#pragma unroll 4
        for (int ks = 0; ks < nks; ++ks) {
            bf16x8 af[MT], bfv[NT];
#pragma unroll
            for (int mt = 0; mt < MT; ++mt) af[mt] = *(const bf16x8*)(ap + (size_t)mt * 16 * K + ks * 32);
#pragma unroll
            for (int nt = 0; nt < NT; ++nt) bfv[nt] = *(const bf16x8*)(bp + (size_t)nt * 16 * K + ks * 32);
#pragma unroll
            for (int mt = 0; mt < MT; ++mt)
#pragma unroll
                for (int nt = 0; nt < NT; ++nt) acc[mt][nt] = MFMA16(bfv[nt], af[mt], acc[mt][nt]);
        }
        LAS float* pw = (LAS float*)(lds + w * WB);
#pragma unroll
        for (int mt = 0; mt < MT; ++mt)
#pragma unroll
            for (int nt = 0; nt < NT; ++nt) *(LAS f32x4*)(pw + (16 * mt + fr) * RS + 16 * nt + 4 * fq) = acc[mt][nt];
        __syncthreads();
#pragma unroll
        for (int q = tid; q < MT * 16 * QPR; q += 512) { const int row = q / QPR, qc = q % QPR;
            f32x4 v = {0.f, 0.f, 0.f, 0.f};
#pragma unroll
            for (int ww = 0; ww < 8; ++ww) v = v + *(const LAS f32x4*)(lds + ww * WB + (row * RS + qc * 4) * 4);
            E.template tailq<QPR>(r0 + row, c0 + qc * 4, v, c0); }
        __syncthreads();
    }
}

template <int MODE>
__device__ __forceinline__ void transpose_item(const float* W, int K, int Nsrc, const float* g, bf16_t* WT, LAS float* scr, int kb, int nb, int lane) {
    const int k0 = 64 * kb, n0 = 32 * nb, nd = n0 + (lane & 7) * 4;
    int src = nd;
    if (MODE == 1) src = nd < 4096 ? nd : (nd < 7168 ? nd + 16 : (nd < 7184 ? nd - 7168 + 4096 : -1));
#pragma unroll
    for (int i = 0; i < 8; ++i) { const int kk = 8 * i + (lane >> 3); f32x4 v = {0.f, 0.f, 0.f, 0.f};
        if (src >= 0) { v = *(const f32x4*)(W + (size_t)(k0 + kk) * Nsrc + src); if (g) v = v * g[k0 + kk]; }
        LAS float* d = scr + kk * 33 + (lane & 7) * 4; d[0] = v[0]; d[1] = v[1]; d[2] = v[2]; d[3] = v[3]; }
    WAVE_LDS_FENCE();
    const int c = lane & 7;
#pragma unroll
    for (int j = 0; j < 4; ++j) { const int n = (lane >> 3) + 8 * j; const LAS float* s = scr + (8 * c) * 33 + n;
        u32x4 o; o.x = pk2(s[0 * 33], s[1 * 33]); o.y = pk2(s[2 * 33], s[3 * 33]); o.z = pk2(s[4 * 33], s[5 * 33]); o.w = pk2(s[6 * 33], s[7 * 33]);
        *(u32x4*)(WT + (size_t)(n0 + n) * K + k0 + 8 * c) = o; }
    WAVE_LDS_FENCE();
}

__device__ __forceinline__ void prep_weights(const Ctx& P, LAS unsigned char* lds, int l, int gw, int NGW) {
    const int tid = opaque_tid(), lane = tid & 63, w = __builtin_amdgcn_readfirstlane(tid >> 6);
    LAS float* scr = (LAS float*)(lds + w * 16384);
    unsigned char* ws = P.ws;
    constexpr int I_IN = 16 * 232, I_SQ = 16 * 32, I_UP = 16 * 192, I_DN = 48 * 32, I_L = I_IN + 3 * I_SQ + I_UP + I_DN;
    const float* p_win = INP(P, 8); const float* p_g1 = INP(P, 7); const float* p_wa = INP(P, 19); const float* p_wb = INP(P, 20); const float* p_wo = INP(P, 21); const float* p_wup = INP(P, 23); const float* p_g2 = INP(P, 22); const float* p_wdn = INP(P, 26);
    for (int it = gw; it < I_L; it += NGW) {
        int r = it;
        if (r < I_IN) { transpose_item<1>(p_win + (size_t)l * D * 7184, D, 7184, p_g1 + l * D, (bf16_t*)(ws + WS_WIN) + (size_t)l * NZ * D, scr, r / 232, r % 232, lane); continue; } r -= I_IN;
        if (r < I_SQ) { transpose_item<0>(p_wa + (size_t)l * D * D, D, D, nullptr, (bf16_t*)(ws + WS_WA) + (size_t)l * D * D, scr, r / 32, r % 32, lane); continue; } r -= I_SQ;
        if (r < I_SQ) { transpose_item<0>(p_wb + (size_t)l * D * D, D, D, nullptr, (bf16_t*)(ws + WS_WB) + (size_t)l * D * D, scr, r / 32, r % 32, lane); continue; } r -= I_SQ;
        if (r < I_SQ) { transpose_item<0>(p_wo + (size_t)l * D * D, D, D, nullptr, (bf16_t*)(ws + WS_WO) + (size_t)l * D * D, scr, r / 32, r % 32, lane); continue; } r -= I_SQ;
        if (r < I_UP) { transpose_item<0>(p_wup + (size_t)l * D * DUP, D, DUP, p_g2 + l * D, (bf16_t*)(ws + WS_WUP) + (size_t)l * DUP * D, scr, r / 192, r % 192, lane); continue; } r -= I_UP;
        transpose_item<0>(p_wdn + (size_t)l * DFF * D, DFF, D, nullptr, (bf16_t*)(ws + WS_WDN) + (size_t)l * D * DFF, scr, r / 32, r % 32, lane);
    }
    { bf16_t* RGW = (bf16_t*)(ws + WS_RGW); const float* p_wx = INP(P, 13); const float* p_wa2 = INP(P, 11);
      for (int j = gw * 64 + lane; j < 2 * 16 * 64 * 64; j += NGW * 64) { const int i = l * (2 * 16 * 64 * 64) + j;
          const int c = i & 63, d = (i >> 6) & 63, blk = (i >> 12) & 15, g = (i >> 16) & 1;
          const float* src = (g ? p_wx : p_wa2) + (((size_t)l * 16 + blk) * 64 + c) * 64 + d;
          RGW[i] = f2bf(*src); } }
}
__device__ __forceinline__ void phase0(const Ctx& P, LAS unsigned char* lds) {
    const int tid = opaque_tid(), lane = tid & 63, w = __builtin_amdgcn_readfirstlane(tid >> 6), bid = opaque_bid();
    const int gw = bid * 8 + w, NGW = gridDim.x * 8;
    unsigned char* ws = P.ws;
    prep_weights(P, lds, 0, gw, NGW);
    bf16_t* XB = (bf16_t*)(ws + WS_XB); float* ss = (float*)(ws + WS_SS);
    const float* p_meta = INP(P, 6); const float* p_xp = INP(P, 0); const float* p_xs = INP(P, 1);
    for (int row = gw; row < M; row += NGW) {
        const float* src;
        if (row < MP) { const int b = row / TP, t = row % TP; src = t < 16 ? p_meta + (size_t)t * D : p_xp + ((size_t)b * 2048 + (t - 16)) * D; }
        else src = p_xs + (size_t)(row - MP) * D;
        float sq = 0.f;
#pragma unroll
        for (int j = 0; j < 4; ++j) { const f32x4 v = *(const f32x4*)(src + j * 256 + lane * 4);
            u32x2 o; o.x = pk2(v[0], v[1]); o.y = pk2(v[2], v[3]); *(u32x2*)(XB + (size_t)row * D + j * 256 + lane * 4) = o;
            sq += (v[0] * v[0] + v[1] * v[1]) + (v[2] * v[2] + v[3] * v[3]); }
#pragma unroll
        for (int o = 1; o < 64; o <<= 1) sq += __shfl_xor(sq, o);
        if (lane < 16) ss[(size_t)row * 16 + lane] = lane == 0 ? sq : 0.f;
    }
}

__device__ __forceinline__ void rg_gates16(LAS unsigned char* wl, const float (&xc)[16], const bf16x8 (&bw)[2][4][2], float ba, float bx, float sp8, int lane, float (&a)[16], float (&bb)[16]) {
    LAS bf16_t* XC = (LAS bf16_t*)wl;
    LAS float* PR = (LAS float*)(wl + 2304);
    const int fr = lane & 15, fq = lane >> 4;
#pragma unroll
    for (int i = 0; i < 16; ++i) XC[i * 72 + lane] = f2bf(xc[i]);
    WAVE_LDS_FENCE();
    bf16x8 af[2];
#pragma unroll
    for (int ks = 0; ks < 2; ++ks) af[ks] = *(const LAS bf16x8*)(wl + fr * 144 + ks * 64 + fq * 16);
#pragma unroll
    for (int g = 0; g < 2; ++g)
#pragma unroll
        for (int ct = 0; ct < 4; ++ct) { f32x4 acc = {0.f, 0.f, 0.f, 0.f};
#pragma unroll
            for (int ks = 0; ks < 2; ++ks) acc = MFMA16(af[ks], bw[g][ct][ks], acc);
#pragma unroll
            for (int j = 0; j < 4; ++j) PR[g * 16 * 68 + (fq * 4 + j) * 68 + 16 * ct + fr] = acc[j]; }
    WAVE_LDS_FENCE();
    float prr[16], pri[16];
#pragma unroll
    for (int i = 0; i < 16; ++i) { prr[i] = PR[i * 68 + lane]; pri[i] = PR[16 * 68 + i * 68 + lane]; }
    __builtin_amdgcn_sched_barrier(0);
#pragma unroll
    for (int i = 0; i < 16; ++i) { const float r = sigm(prr[i] + ba), ig = sigm(pri[i] + bx);
        const float la = -sp8 * r; const float av = __expf(la); a[i] = av; bb[i] = __builtin_amdgcn_sqrtf(fmaxf(1.f - av * av, 0.f)) * (ig * xc[i]); }
    WAVE_LDS_FENCE();
}
struct RgConst { float cw0, cw1, cw2, cw3, cb, ba, bx, sp8; };
__device__ __forceinline__ void rg_load_const(const Ctx& P, int l, int ch, int nb, int lane, RgConst& c, bf16x8 (&bw)[2][4][2]) {
    const float* p_cw = INP(P, 9);
    c.cw0 = p_cw[(size_t)(l * 4 + 0) * D + ch]; c.cw1 = p_cw[(size_t)(l * 4 + 1) * D + ch]; c.cw2 = p_cw[(size_t)(l * 4 + 2) * D + ch]; c.cw3 = p_cw[(size_t)(l * 4 + 3) * D + ch];
    c.cb = INP(P, 10)[l * D + ch]; c.ba = INP(P, 12)[l * D + ch]; c.bx = INP(P, 14)[l * D + ch]; c.sp8 = 8.f * softplus_(-INP(P, 15)[l * D + ch]);
    const bf16_t* RGW = (const bf16_t*)(P.ws + WS_RGW);
    const int fr = lane & 15, fq = lane >> 4;
#pragma unroll
    for (int g = 0; g < 2; ++g)
#pragma unroll
        for (int ct = 0; ct < 4; ++ct)
#pragma unroll
            for (int ks = 0; ks < 2; ++ks) bw[g][ct][ks] = *(const bf16x8*)(RGW + ((((size_t)l * 2 + g) * 16 + nb) * 64 + 16 * ct + fr) * 64 + ks * 32 + fq * 8);
}
__device__ __forceinline__ void rg_prompt_item(const Ctx& P, int l, int wi, LAS unsigned char* wl, int lane) {
    const int nb = wi & 15, c = wi < 4096 ? 1 + ((wi >> 4) & 31) : 0, b = wi < 4096 ? wi >> 9 : (wi - 4096) >> 4;
    const int L = c == 0 ? 16 : 64, t0 = c == 0 ? 0 : 16 + 64 * (c - 1), row0 = b * TP + t0, ch = nb * 64 + lane;
    const bf16_t* Z = (const bf16_t*)(P.ws + WS_Z); bf16_t* HG = (bf16_t*)(P.ws + WS_HG); bf16_t* A2 = (bf16_t*)(P.ws + WS_T); float* CAR = (float*)(P.ws + WS_CARRY);
    RgConst k; bf16x8 bw[2][4][2]; rg_load_const(P, l, ch, nb, lane, k, bw);
    float xm3 = 0.f, xm2 = 0.f, xm1 = 0.f;
    if (t0 > 0) { xm3 = bf2f(Z[(size_t)(row0 - 3) * NZ + ch]); xm2 = bf2f(Z[(size_t)(row0 - 2) * NZ + ch]); xm1 = bf2f(Z[(size_t)(row0 - 1) * NZ + ch]); }
    float h = 0.f, pacc = 1.f;
    unsigned xr[16], yr[16];
#pragma unroll
    for (int i = 0; i < 16; ++i) { xr[i] = Z[(size_t)(row0 + i) * NZ + ch]; yr[i] = Z[(size_t)(row0 + i) * NZ + ZC_RGY + ch]; }
    for (int sub = 0; sub < L / 16; ++sub) {
        const int r0 = row0 + sub * 16;
        float xc[16], a[16], bb[16], gl[16];
#pragma unroll
        for (int i = 0; i < 16; ++i) { const float xn = bf2f(xr[i]);
            xc[i] = k.cb + k.cw0 * xm3 + k.cw1 * xm2 + k.cw2 * xm1 + k.cw3 * xn; xm3 = xm2; xm2 = xm1; xm1 = xn; gl[i] = gelu_t(bf2f(yr[i])); }
        if (sub + 1 < L / 16) {
#pragma unroll
            for (int i = 0; i < 16; ++i) { xr[i] = Z[(size_t)(r0 + 16 + i) * NZ + ch]; yr[i] = Z[(size_t)(r0 + 16 + i) * NZ + ZC_RGY + ch]; } }
        rg_gates16(wl, xc, bw, k.ba, k.bx, k.sp8, lane, a, bb);
#pragma unroll
        for (int i = 0; i < 16; ++i) { h = a[i] * h + bb[i]; pacc *= a[i];
            HG[(size_t)(r0 + i) * D + ch] = f2bf(h * gl[i]); A2[(size_t)(r0 + i) * D + ch] = f2bf(pacc * gl[i]); }
    }
    { f32x2 ph = {pacc, h}; *(f32x2*)(CAR + (((size_t)b * NCH + c) * 1024 + ch) * 2) = ph; }
    if (c == NCH - 1) { float* rc = P.out + O_RCP + (((size_t)l * NB + b) * 3) * D + ch; rc[0] = xm3; rc[D] = xm2; rc[2 * D] = xm1; }
}
__device__ __forceinline__ void rg_fix_item(const Ctx& P, int l, int wi, int lane) {
    const int nb = wi & 15, c = (wi >> 4) % NCH, b = wi / (16 * NCH);
    const int L = c == 0 ? 16 : 64, t0 = c == 0 ? 0 : 16 + 64 * (c - 1), row0 = b * TP + t0, ch = nb * 64 + lane;
    bf16_t* HG = (bf16_t*)(P.ws + WS_HG); const bf16_t* A2 = (const bf16_t*)(P.ws + WS_T); const float* CAR = (const float*)(P.ws + WS_CARRY);
    float h = 0.f;
    for (int cc = 0; cc < c; ++cc) { const f32x2 ph = *(const f32x2*)(CAR + (((size_t)b * NCH + cc) * 1024 + ch) * 2); h = ph.x * h + ph.y; }
    if (c > 0) {
#pragma unroll
        for (int hf = 0; hf < 2; ++hf) { unsigned a1[32], a2[32];
#pragma unroll
            for (int i = 0; i < 32; ++i) { a1[i] = HG[(size_t)(row0 + hf * 32 + i) * D + ch]; a2[i] = A2[(size_t)(row0 + hf * 32 + i) * D + ch]; }
#pragma unroll
            for (int i = 0; i < 32; ++i) HG[(size_t)(row0 + hf * 32 + i) * D + ch] = f2bf(bf2f(a1[i]) + bf2f(a2[i]) * h); } }
    if (c == NCH - 1) { const f32x2 ph = *(const f32x2*)(CAR + (((size_t)b * NCH + c) * 1024 + ch) * 2); P.out[O_RHP + ((size_t)l * NB + b) * D + ch] = ph.x * h + ph.y; }
}
__device__ __forceinline__ void rg_sample_item(const Ctx& P, int l, int wi, LAS unsigned char* wl, int lane) {
    const int nb = wi & 15, sg = wi >> 4, ch = nb * 64 + lane;
    const bf16_t* Z = (const bf16_t*)(P.ws + WS_Z); bf16_t* HG = (bf16_t*)(P.ws + WS_HG);
    RgConst k; bf16x8 bw[2][4][2]; rg_load_const(P, l, ch, nb, lane, k, bw);
    const float* p_st = INP(P, 2); const float* p_h0 = INP(P, 3);
    float xc[16], a[16], bb[16];
#pragma unroll
    for (int i = 0; i < 16; ++i) { const int s = sg * 16 + i; const float* st = p_st + (((size_t)l * NS + s) * 3) * D + ch;
        const float s0 = st[0], s1 = st[D], s2 = st[2 * D], xn = bf2f(Z[(size_t)(MP + s) * NZ + ch]);
        xc[i] = k.cb + k.cw0 * s0 + k.cw1 * s1 + k.cw2 * s2 + k.cw3 * xn;
        float* rc = P.out + O_RCS + (((size_t)l * NS + s) * 3) * D + ch; rc[0] = s1; rc[D] = s2; rc[2 * D] = xn; }
    rg_gates16(wl, xc, bw, k.ba, k.bx, k.sp8, lane, a, bb);
#pragma unroll
    for (int i = 0; i < 16; ++i) { const int s = sg * 16 + i; const float h0 = p_h0[((size_t)l * NS + s) * D + ch];
        const float h = a[i] * h0 + bb[i];
        P.out[O_RHS + ((size_t)l * NS + s) * D + ch] = h;
        const float y = bf2f(Z[(size_t)(MP + s) * NZ + ZC_RGY + ch]); HG[(size_t)(MP + s) * D + ch] = f2bf(h * gelu_t(y)); }
}

__device__ __forceinline__ void gla_qk_item(const Ctx& P, int l, int wi, LAS unsigned char* wl, int lane) {
    const int half = wi & 1, h = (wi >> 1) & 3, c = (wi >> 3) % NCH, b = wi / (8 * NCH);
    const int L = c == 0 ? 16 : 64, t0 = c == 0 ? 0 : 16 + 64 * (c - 1), row0 = b * TP + t0, d = half * 64 + lane, col = h * 128 + d;
    const bf16_t* Z = (const bf16_t*)(P.ws + WS_Z);
    LAS float* BC = (LAS float*)wl;
    float wg[16]; const float* p_wg = INP(P, 16);
#pragma unroll
    for (int r = 0; r < 16; ++r) wg[r] = p_wg[((size_t)l * 16 + r) * 512 + col];
    const float bg = INP(P, 17)[l * 512 + col];
    float gv[16];
    { u32x4 g0 = {0u, 0u, 0u, 0u}, g1 = {0u, 0u, 0u, 0u};
      if (lane < L) { g0 = *(const u32x4*)(Z + (size_t)(row0 + lane) * NZ + ZC_GLR); g1 = *(const u32x4*)(Z + (size_t)(row0 + lane) * NZ + ZC_GLR + 8); }
      gv[0] = bflo(g0.x); gv[1] = bfhi(g0.x); gv[2] = bflo(g0.y); gv[3] = bfhi(g0.y); gv[4] = bflo(g0.z); gv[5] = bfhi(g0.z); gv[6] = bflo(g0.w); gv[7] = bfhi(g0.w);
      gv[8] = bflo(g1.x); gv[9] = bfhi(g1.x); gv[10] = bflo(g1.y); gv[11] = bfhi(g1.y); gv[12] = bflo(g1.z); gv[13] = bfhi(g1.z); gv[14] = bflo(g1.w); gv[15] = bfhi(g1.w); }
    float run = 0.f;
#pragma unroll 1
    for (int t = 0; t < 64; ++t) {
        if (t < L) { float zg = bg;
#pragma unroll
            for (int r = 0; r < 16; ++r) zg += __int_as_float(__builtin_amdgcn_readlane(__float_as_int(gv[r]), t)) * wg[r];
            run += -softplus_(-zg) * (1.f / 16.f); }
        BC[t * 64 + lane] = run;
    }
    const float bl = run, ebl = __expf(bl);
    const size_t idx = ((size_t)b * NCH + c) * 4 + h;
    bf16_t* QD = (bf16_t*)(P.ws + WS_QD) + idx * 8192; bf16_t* KD = (bf16_t*)(P.ws + WS_KD) + idx * 8192; bf16_t* KET = (bf16_t*)(P.ws + WS_KET) + idx * 8192;
    ((float*)(P.ws + WS_DEC))[((size_t)b * NCH + c) * 512 + col] = ebl;
#pragma unroll 1
    for (int hf = 0; hf < 2; ++hf) { unsigned qr[32], kr[32];
#pragma unroll
        for (int i = 0; i < 32; ++i) { const int t = hf * 32 + i; qr[i] = 0u; kr[i] = 0u;
            if (t < L) { qr[i] = Z[(size_t)(row0 + t) * NZ + ZC_Q + col]; kr[i] = Z[(size_t)(row0 + t) * NZ + ZC_K + col]; } }
#pragma unroll
        for (int t8 = 0; t8 < 4; ++t8) { float ke[8];
#pragma unroll
            for (int i = 0; i < 8; ++i) { const int t = hf * 32 + t8 * 8 + i; const float q = bf2f(qr[t8 * 8 + i]), kk = bf2f(kr[t8 * 8 + i]);
                const float eb = __expf(BC[t * 64 + lane]), ieb = __builtin_amdgcn_rcpf(eb);
                const int po = t * 128 + ((((d >> 3) ^ (t & 15)) << 3) | (d & 7));
                QD[po] = f2bf(q * 0.08838834764831845f * eb); const float kdv = kk * ieb; KD[po] = f2bf(kdv); ke[i] = kdv * ebl; }
            u32x4 o; o.x = pk2(ke[0], ke[1]); o.y = pk2(ke[2], ke[3]); o.z = pk2(ke[4], ke[5]); o.w = pk2(ke[6], ke[7]);
            const int tg = hf * 4 + t8;
            *(u32x4*)(KET + d * 64 + ((tg ^ (d & 7)) << 3)) = o; } }
}
__device__ __forceinline__ void gla_vt_item(const Ctx& P, int wi, int lane) {
    const int eg = wi & 3, h = (wi >> 2) & 3, c = (wi >> 4) % NCH, b = wi / (16 * NCH);
    const int L = c == 0 ? 16 : 64, t0 = c == 0 ? 0 : 16 + 64 * (c - 1), row0 = b * TP + t0, e = eg * 64 + lane;
    const bf16_t* Z = (const bf16_t*)(P.ws + WS_Z);
    bf16_t* VT = (bf16_t*)(P.ws + WS_VT) + (((size_t)b * NCH + c) * 4 + h) * 16384;
    unsigned v[64];
#pragma unroll
    for (int t = 0; t < 64; ++t) v[t] = t < L ? (unsigned)Z[(size_t)(row0 + t) * NZ + ZC_V + h * 256 + e] : 0u;
#pragma unroll
    for (int t8 = 0; t8 < 8; ++t8) { u32x4 o; o.x = v[t8 * 8 + 0] | (v[t8 * 8 + 1] << 16); o.y = v[t8 * 8 + 2] | (v[t8 * 8 + 3] << 16); o.z = v[t8 * 8 + 4] | (v[t8 * 8 + 5] << 16); o.w = v[t8 * 8 + 6] | (v[t8 * 8 + 7] << 16);
        *(u32x4*)(VT + e * 64 + t8 * 8) = o; }
}

__device__ __forceinline__ void gla_prompt_unit(const Ctx& P, int l, int b, int h, int eh, LAS unsigned char* lds) {
    const int tid = opaque_tid(), lane = tid & 63, w = __builtin_amdgcn_readfirstlane(tid >> 6), fr = lane & 15, fq = lane >> 4;
    constexpr int QS = 256, ES = 128, KS = 144, BUFB = 3 * 16384, A_OFF = 3 * BUFB, DEC_OFF = A_OFF + 64 * KS;
    const bf16_t* Z = (const bf16_t*)(P.ws + WS_Z); bf16_t* OG = (bf16_t*)(P.ws + WS_OG);
    const bf16_t* QDg = (const bf16_t*)(P.ws + WS_QD); const bf16_t* KDg = (const bf16_t*)(P.ws + WS_KD); const bf16_t* KETg = (const bf16_t*)(P.ws + WS_KET); const bf16_t* VTg = (const bf16_t*)(P.ws + WS_VT);
    const float* DEC = (const float*)(P.ws + WS_DEC); float* GSS = (float*)(P.ws + WS_GSS);
    const int e0w = eh * 128 + 16 * w;
    LAS unsigned char* Abuf = lds + A_OFF; LAS float* DECL = (LAS float*)(lds + DEC_OFF);
    f32x4 S[8];
#pragma unroll
    for (int dt = 0; dt < 8; ++dt) S[dt] = (f32x4){0.f, 0.f, 0.f, 0.f};
    bf16x8 vt[2], vtA[2], vtB[2];
    const int grp = w >> 2;
#define GLA_VT(dst, cc) do { const size_t _ix = ((size_t)b * NCH + (cc)) * 4 + h; \
        _Pragma("unroll") for (int _ks = 0; _ks < 2; ++_ks) dst[_ks] = *(const bf16x8*)(VTg + _ix * 16384 + (size_t)(e0w + fr) * 64 + _ks * 32 + fq * 8); } while (0)
#define GLA_DMA(cc, bufi, p0, pstep, np) do { const size_t _ix = ((size_t)b * NCH + (cc)) * 4 + h; LAS unsigned char* _bb = lds + (bufi) * BUFB; \
        _Pragma("unroll") for (int _i = 0; _i < (np); ++_i) { const int _pc = (p0) + (pstep) * _i; \
            __builtin_amdgcn_global_load_lds((const unsigned*)((const char*)(QDg + _ix * 8192) + _pc * 1024 + lane * 16), (LAS unsigned*)(_bb + _pc * 1024), 16, 0, 0); \
            __builtin_amdgcn_global_load_lds((const unsigned*)((const char*)(KDg + _ix * 8192) + _pc * 1024 + lane * 16), (LAS unsigned*)(_bb + 16384 + _pc * 1024), 16, 0, 0); \
            __builtin_amdgcn_global_load_lds((const unsigned*)((const char*)(KETg + _ix * 8192) + _pc * 1024 + lane * 16), (LAS unsigned*)(_bb + 32768 + _pc * 1024), 16, 0, 0); } } while (0)
    GLA_VT(vtA, 0); GLA_VT(vtB, 1);
    float d1 = 0.f;
    if (tid < 128) { DECL[tid] = DEC[((size_t)b * NCH) * 512 + h * 128 + tid]; d1 = DEC[((size_t)b * NCH + 1) * 512 + h * 128 + tid]; }
    GLA_DMA(0, 0, w, 8, 2); GLA_DMA(1, 1, w, 8, 2);
    asm volatile("s_waitcnt vmcnt(0)" ::: "memory");
    __syncthreads();
    int bufc = 0;
    for (int c = 0; c < NCH; ++c) {
        const int bufn = bufc == 2 ? 0 : bufc + 1, bufnn = bufn == 2 ? 0 : bufn + 1;
        LAS unsigned char* qb = lds + bufc * BUFB; LAS unsigned char* kb = qb + 16384; LAS unsigned char* eb = qb + 32768;
        vt[0] = vtA[0]; vt[1] = vtA[1]; vtA[0] = vtB[0]; vtA[1] = vtB[1];
        float dnew = 0.f;
        if (c + 2 < NCH) { GLA_VT(vtB, c + 2);
            if (tid < 128) dnew = DEC[((size_t)b * NCH + c + 2) * 512 + h * 128 + tid];
            if (grp == (c & 1)) GLA_DMA(c + 2, bufnn, (w & 3), 4, 4); }
        const int L = c == 0 ? 16 : 64, row0 = b * TP + (c == 0 ? 0 : 16 + 64 * (c - 1));
        { bf16x8 ka[2][4], qv[2][4];
#pragma unroll
          for (int ii = 0; ii < 2; ++ii) { const int idx = 2 * w + ii, si = idx >> 2, ti = idx & 3;
#pragma unroll
              for (int ks = 0; ks < 4; ++ks) { const int sw = ((ks * 4 + fq) ^ fr) * 16; ka[ii][ks] = *(const LAS bf16x8*)(kb + (16 * si + fr) * QS + sw); qv[ii][ks] = *(const LAS bf16x8*)(qb + (16 * ti + fr) * QS + sw); } }
          __builtin_amdgcn_sched_barrier(0);
          f32x4 acc[2];
#pragma unroll
          for (int ii = 0; ii < 2; ++ii) acc[ii] = (f32x4){0.f, 0.f, 0.f, 0.f};
#pragma unroll
          for (int ks = 0; ks < 4; ++ks)
#pragma unroll
              for (int ii = 0; ii < 2; ++ii) acc[ii] = MFMA16(ka[ii][ks], qv[ii][ks], acc[ii]);
#pragma unroll
          for (int ii = 0; ii < 2; ++ii) { const int idx = 2 * w + ii, si = idx >> 2, ti = idx & 3;
              const int t = 16 * ti + fr;
              float a0 = acc[ii][0], a1 = acc[ii][1], a2 = acc[ii][2], a3 = acc[ii][3]; const int s0 = 16 * si + fq * 4;
              if (s0 + 0 > t) a0 = 0.f; if (s0 + 1 > t) a1 = 0.f; if (s0 + 2 > t) a2 = 0.f; if (s0 + 3 > t) a3 = 0.f;
              u32x2 ow; ow.x = pk2(a0, a1); ow.y = pk2(a2, a3);
              *(LAS u32x2*)(Abuf + t * KS + s0 * 2) = ow; } }
        __syncthreads();
        f32x4 o[4];
        { bf16x8 af[2][4]; u32x2 q0[4][4], q1[4][4];
#pragma unroll
          for (int ks = 0; ks < 2; ++ks)
#pragma unroll
              for (int tt = 0; tt < 4; ++tt) af[ks][tt] = *(const LAS bf16x8*)(Abuf + (16 * tt + fr) * KS + ks * 64 + fq * 16);
#pragma unroll
          for (int ks = 0; ks < 4; ++ks)
#pragma unroll
              for (int tt = 0; tt < 4; ++tt) { q0[ks][tt] = *(const LAS u32x2*)(qb + (16 * tt + fr) * QS + (((4 * ks + (fq >> 1)) ^ fr) * 16) + 8 * (fq & 1)); q1[ks][tt] = *(const LAS u32x2*)(qb + (16 * tt + fr) * QS + (((4 * ks + 2 + (fq >> 1)) ^ fr) * 16) + 8 * (fq & 1)); }
          bf16x8 sa[4];
#pragma unroll
          for (int ks = 0; ks < 4; ++ks) { u32x4 pw; pw.x = pk2(S[2 * ks][0], S[2 * ks][1]); pw.y = pk2(S[2 * ks][2], S[2 * ks][3]); pw.z = pk2(S[2 * ks + 1][0], S[2 * ks + 1][1]); pw.w = pk2(S[2 * ks + 1][2], S[2 * ks + 1][3]); sa[ks] = __builtin_bit_cast(bf16x8, pw); }
          __builtin_amdgcn_sched_barrier(0);
#pragma unroll
          for (int tt = 0; tt < 4; ++tt) o[tt] = (f32x4){0.f, 0.f, 0.f, 0.f};
#pragma unroll
          for (int ks = 0; ks < 2; ++ks)
#pragma unroll
              for (int tt = 0; tt < 4; ++tt) o[tt] = MFMA16(vt[ks], af[ks][tt], o[tt]);
#pragma unroll
          for (int ks = 0; ks < 4; ++ks)
#pragma unroll
              for (int tt = 0; tt < 4; ++tt) { u32x4 qw; qw.x = q0[ks][tt].x; qw.y = q0[ks][tt].y; qw.z = q1[ks][tt].x; qw.w = q1[ks][tt].y;
                  o[tt] = MFMA16(sa[ks], __builtin_bit_cast(bf16x8, qw), o[tt]); } }
        __builtin_amdgcn_sched_barrier(0);
        { const LAS float* dp = DECL + bufc * 128; bf16x8 kf[8][2]; f32x4 dv[8];
#pragma unroll
          for (int dt = 0; dt < 8; ++dt) { dv[dt] = *(const LAS f32x4*)(dp + 16 * dt + fq * 4);
#pragma unroll
              for (int ks = 0; ks < 2; ++ks) kf[dt][ks] = *(const LAS bf16x8*)(eb + (16 * dt + fr) * ES + (((ks * 4 + fq) ^ (fr & 7)) * 16)); }
          __builtin_amdgcn_sched_barrier(0);
#pragma unroll
          for (int dt = 0; dt < 8; ++dt) S[dt] = S[dt] * dv[dt];
#pragma unroll
          for (int ks = 0; ks < 2; ++ks)
#pragma unroll
              for (int dt = 0; dt < 8; ++dt) S[dt] = MFMA16(kf[dt][ks], vt[ks], S[dt]); }
        __builtin_amdgcn_sched_barrier(0);
        if (grp == ((c + 1) & 1)) asm volatile("s_waitcnt vmcnt(0)" ::: "memory");
        if (c + 1 < NCH && tid < 128) DECL[bufn * 128 + tid] = d1;
        d1 = dnew;
#pragma unroll
        for (int tt = 0; tt < 4; ++tt) { const int t = 16 * tt + fr;
            u32x4 sqw; sqw.x = pk2(o[tt][0] * o[tt][0], o[tt][1] * o[tt][1]); sqw.y = pk2(o[tt][2] * o[tt][2], o[tt][3] * o[tt][3]); sqw.z = 0u; sqw.w = 0u;
            const u32x4 onesw = {0x3F803F80u, 0x3F803F80u, 0x3F803F80u, 0x3F803F80u};
            const f32x4 red = MFMA16(__builtin_bit_cast(bf16x8, onesw), __builtin_bit_cast(bf16x8, sqw), ((f32x4){0.f, 0.f, 0.f, 0.f}));
            const float p = red[0];
            if (t < L) { const size_t row = (size_t)(row0 + t);
                u32x2 ow; ow.x = pk2(o[tt][0], o[tt][1]); ow.y = pk2(o[tt][2], o[tt][3]);
                *(u32x2*)(OG + row * D + h * 256 + e0w + fq * 4) = ow;
                if (fq == 0) GSS[(row * 4 + h) * 16 + eh * 8 + w] = p; } }
        __syncthreads();
        bufc = bufn;
    }
    { float* gp = P.out + O_GP + (((size_t)l * NB + b) * 4 + h) * 128 * 256;
#pragma unroll
      for (int dt = 0; dt < 8; ++dt)
#pragma unroll
          for (int j = 0; j < 4; ++j) gp[(size_t)(16 * dt + fq * 4 + j) * 256 + e0w + fr] = S[dt][j]; }
#undef GLA_VT
#undef GLA_DMA
}

__device__ __forceinline__ void unpack8(const u32x4 w, float (&f)[8]) { f[0] = bflo(w.x); f[1] = bfhi(w.x); f[2] = bflo(w.y); f[3] = bfhi(w.y); f[4] = bflo(w.z); f[5] = bfhi(w.z); f[6] = bflo(w.w); f[7] = bfhi(w.w); }
__device__ __forceinline__ void load8f(const float* p, float (&f)[8]) { const f32x4 a = *(const f32x4*)p, b = *(const f32x4*)(p + 4); f[0] = a[0]; f[1] = a[1]; f[2] = a[2]; f[3] = a[3]; f[4] = b[0]; f[5] = b[1]; f[6] = b[2]; f[7] = b[3]; }
__device__ __forceinline__ void store8f(float* p, const float (&f)[8]) { *(f32x4*)p = (f32x4){f[0], f[1], f[2], f[3]}; *(f32x4*)(p + 4) = (f32x4){f[4], f[5], f[6], f[7]}; }
__device__ __forceinline__ void gla_finalize(const Ctx& P, int l) {
    const bf16_t* Z = (const bf16_t*)(P.ws + WS_Z); bf16_t* OG = (bf16_t*)(P.ws + WS_OG); const float* GSS = (const float*)(P.ws + WS_GSS);
    const float* p_gn = INP(P, 18) + (size_t)l * 1024;
    const int gt = opaque_bid() * 512 + opaque_tid(), NT = gridDim.x * 512;
    for (int it0 = gt; it0 < MP * 128; it0 += 4 * NT) {
        u32x4 ovw[4], gvw[4]; float rs[4];
#pragma unroll
        for (int u = 0; u < 4; ++u) { const int it = it0 + u * NT; if (it < MP * 128) { const int row = it >> 7, c8 = (it & 127) * 8, h = c8 >> 8;
            ovw[u] = *(const u32x4*)(OG + (size_t)row * D + c8); gvw[u] = *(const u32x4*)(Z + (size_t)row * NZ + ZC_GOUT + c8);
            rs[u] = rsqrtf(ss_total(GSS + (size_t)h * 16, row * 4) * (1.f / 256.f) + EPS); } }
#pragma unroll
        for (int u = 0; u < 4; ++u) { const int it = it0 + u * NT; if (it < MP * 128) { const int row = it >> 7, c8 = (it & 127) * 8;
            float ov[8], gv[8], gn[8]; unpack8(ovw[u], ov); unpack8(gvw[u], gv); load8f(p_gn + c8, gn);
#pragma unroll
            for (int i = 0; i < 8; ++i) ov[i] = ov[i] * rs[u] * gn[i] * silu_(gv[i]);
            u32x4 o; o.x = pk2(ov[0], ov[1]); o.y = pk2(ov[2], ov[3]); o.z = pk2(ov[4], ov[5]); o.w = pk2(ov[6], ov[7]);
            *(u32x4*)(OG + (size_t)row * D + c8) = o; } }
    }
}

__device__ __forceinline__ void gla_sample_item(const Ctx& P, int l, int s, int h, LAS unsigned char* lds) {
    const int tid = opaque_tid(), lane = tid & 63, w = __builtin_amdgcn_readfirstlane(tid >> 6);
    LAS float* AL = (LAS float*)lds; LAS float* KK = AL + 128; LAS float* QQ = KK + 128; LAS float* OP = QQ + 128; LAS float* RED = OP + 8 * 256;
    const bf16_t* Z = (const bf16_t*)(P.ws + WS_Z); bf16_t* OG = (bf16_t*)(P.ws + WS_OG);
    const size_t row = (size_t)(MP + s);
    const float* p_wg = INP(P, 16); const float* p_bg = INP(P, 17); const float* p_s0 = INP(P, 4); const float* p_gn = INP(P, 18);
    if (tid < 128) { const int col = h * 128 + tid; float zg = p_bg[l * 512 + col];
#pragma unroll
        for (int r = 0; r < 16; ++r) zg += bf2f(Z[row * NZ + ZC_GLR + r]) * p_wg[((size_t)l * 16 + r) * 512 + col];
        AL[tid] = __expf(-softplus_(-zg) * (1.f / 16.f)); KK[tid] = bf2f(Z[row * NZ + ZC_K + col]); QQ[tid] = bf2f(Z[row * NZ + ZC_Q + col]) * 0.08838834764831845f; }
    __syncthreads();
    { const int e0 = lane * 4; const u32x2 vw = *(const u32x2*)(Z + row * NZ + ZC_V + h * 256 + e0);
      const f32x4 v4 = {bflo(vw.x), bfhi(vw.x), bflo(vw.y), bfhi(vw.y)}; f32x4 o4 = {0.f, 0.f, 0.f, 0.f};
      const size_t sb = (((size_t)l * NS + s) * 4 + h) * 128 * 256;
      const float* S0 = p_s0 + sb; float* SO = P.out + O_GS + sb;
      f32x4 s0[16];
#pragma unroll
      for (int dd = 0; dd < 16; ++dd) s0[dd] = *(const f32x4*)(S0 + (size_t)(16 * w + dd) * 256 + e0);
#pragma unroll
      for (int dd = 0; dd < 16; ++dd) { const int d = 16 * w + dd;
          const f32x4 sn = s0[dd] * AL[d] + v4 * KK[d]; *(f32x4*)(SO + (size_t)d * 256 + e0) = sn; o4 = o4 + sn * QQ[d]; }
      *(LAS f32x4*)(OP + w * 256 + e0) = o4; }
    __syncthreads();
    float ov = 0.f;
    if (tid < 256) {
#pragma unroll
        for (int ww = 0; ww < 8; ++ww) ov += OP[ww * 256 + tid];
        float p = ov * ov;
#pragma unroll
        for (int o = 1; o < 64; o <<= 1) p += __shfl_xor(p, o);
        if (lane == 0) RED[w] = p; }
    __syncthreads();
    if (tid < 256) { const float tot = RED[0] + RED[1] + RED[2] + RED[3]; const float rs = rsqrtf(tot * (1.f / 256.f) + EPS);
        const float gn = p_gn[((size_t)l * 4 + h) * 256 + tid]; const float go = bf2f(Z[row * NZ + ZC_GOUT + h * 256 + tid]);
        OG[row * D + h * 256 + tid] = f2bf(ov * rs * gn * silu_(go)); }
    __syncthreads();
}

__device__ __forceinline__ void phase_geglu(const Ctx& P, int l) {
    const bf16_t* U = (const bf16_t*)(P.ws + WS_U); bf16_t* ACT = (bf16_t*)(P.ws + WS_ACT);
    const float* cw = INP(P, 24) + (size_t)l * 3 * DUP; const float* cbp = INP(P, 25) + (size_t)l * DUP; const float* p_fst = INP(P, 5);
    const int gt = opaque_bid() * 512 + opaque_tid(), NT = gridDim.x * 512;
    constexpr int NCG = DFF / 8, NRUN = MP / 8;
    for (int it = gt; it < NCG * (NRUN + NS); it += NT) {
        const int cg8 = it % NCG, run = it / NCG, f0 = cg8 * 8;
        float wg[3][8], wv[3][8], bg[8], bv[8];
#pragma unroll
        for (int j = 0; j < 3; ++j) { load8f(cw + (size_t)j * DUP + f0, wg[j]); load8f(cw + (size_t)j * DUP + DFF + f0, wv[j]); }
        load8f(cbp + f0, bg); load8f(cbp + DFF + f0, bv);
        float g2[8], g1[8], v2[8], v1[8];
        if (run < NRUN) {
            const int b = run / 258, t0 = (run % 258) * 8; const size_t row0 = (size_t)b * TP + t0;
            if (t0 == 0) {
#pragma unroll
                for (int i = 0; i < 8; ++i) { g2[i] = g1[i] = v2[i] = v1[i] = 0.f; }
            } else { unpack8(*(const u32x4*)(U + (row0 - 2) * DUP + f0), g2); unpack8(*(const u32x4*)(U + (row0 - 1) * DUP + f0), g1);
                     unpack8(*(const u32x4*)(U + (row0 - 2) * DUP + DFF + f0), v2); unpack8(*(const u32x4*)(U + (row0 - 1) * DUP + DFF + f0), v1); }
            u32x4 ug8[8], uv8[8];
#pragma unroll
            for (int r = 0; r < 8; ++r) { ug8[r] = *(const u32x4*)(U + (row0 + r) * DUP + f0); uv8[r] = *(const u32x4*)(U + (row0 + r) * DUP + DFF + f0); }
#pragma unroll
            for (int r = 0; r < 8; ++r) { float g0[8], v0[8], a[8];
                unpack8(ug8[r], g0); unpack8(uv8[r], v0);
#pragma unroll
                for (int i = 0; i < 8; ++i) { const float ug = bg[i] + wg[0][i] * g2[i] + wg[1][i] * g1[i] + wg[2][i] * g0[i], uv = bv[i] + wv[0][i] * v2[i] + wv[1][i] * v1[i] + wv[2][i] * v0[i];
                    a[i] = gelu_t(ug) * uv; g2[i] = g1[i]; g1[i] = g0[i]; v2[i] = v1[i]; v1[i] = v0[i]; }
                u32x4 o; o.x = pk2(a[0], a[1]); o.y = pk2(a[2], a[3]); o.z = pk2(a[4], a[5]); o.w = pk2(a[6], a[7]);
                *(u32x4*)(ACT + (row0 + r) * DFF + f0) = o; }
            if (t0 == TP - 8) { float* fo = P.out + O_FCP + (((size_t)l * NB + b) * 2) * DUP;
                store8f(fo + f0, g2); store8f(fo + DUP + f0, g1); store8f(fo + DFF + f0, v2); store8f(fo + DUP + DFF + f0, v1); }
        } else {
            const int s = run - NRUN; const size_t row = (size_t)MP + s;
            const float* st = p_fst + (((size_t)l * NS + s) * 2) * DUP;
            load8f(st + f0, g2); load8f(st + DUP + f0, g1); load8f(st + DFF + f0, v2); load8f(st + DUP + DFF + f0, v1);
            float g0[8], v0[8], a[8];
            unpack8(*(const u32x4*)(U + row * DUP + f0), g0); unpack8(*(const u32x4*)(U + row * DUP + DFF + f0), v0);
#pragma unroll
            for (int i = 0; i < 8; ++i) { const float ug = bg[i] + wg[0][i] * g2[i] + wg[1][i] * g1[i] + wg[2][i] * g0[i], uv = bv[i] + wv[0][i] * v2[i] + wv[1][i] * v1[i] + wv[2][i] * v0[i];
                a[i] = gelu_t(ug) * uv; }
            u32x4 o; o.x = pk2(a[0], a[1]); o.y = pk2(a[2], a[3]); o.z = pk2(a[4], a[5]); o.w = pk2(a[6], a[7]);
            *(u32x4*)(ACT + row * DFF + f0) = o;
            float* fo = P.out + O_FCS + (((size_t)l * NS + s) * 2) * DUP;
            store8f(fo + f0, g1); store8f(fo + DUP + f0, g0); store8f(fo + DFF + f0, v1); store8f(fo + DUP + DFF + f0, v0);
        }
    }
}

#define XB_TMO      128
#define XB_XCNT(j)  (256  + 64 * (j))
#define XB_XSUB(j)  (1280 + 64 * (j))
#define XB_XGEN(j)  (2304 + 64 * (j))
#define XB_TOP      3328
#define XB_TOPGEN   3392
#define XCD_BAR_WORDS 3456
#define XB_SPIN_CAP (1u << 18)

__device__ __forceinline__ unsigned xb_ld(unsigned* p)              { return __hip_atomic_load(p, __ATOMIC_RELAXED, __HIP_MEMORY_SCOPE_AGENT); }
__device__ __forceinline__ unsigned xb_add(unsigned* p, unsigned v) { return __hip_atomic_fetch_add(p, v, __ATOMIC_RELAXED, __HIP_MEMORY_SCOPE_AGENT); }
__device__ __forceinline__ unsigned xb_xcc_id() { return (unsigned)__builtin_amdgcn_s_getreg((3 << 11) | 20) & 0xFu; }
#define XB_SPIN(cond, bar) do { unsigned _sp = 0; while (cond) { __builtin_amdgcn_s_sleep(1); \
    if ((++_sp & 255u) == 0u) { if (xb_ld(&(bar)[XB_TMO])) break; if (_sp > XB_SPIN_CAP) { atomicAdd(&(bar)[XB_TMO], 1u); break; } } } } while (0)

struct XcdBarrier {
    unsigned* bar; unsigned x;
    volatile LAS unsigned* st;
};

__device__ __forceinline__ XcdBarrier xcd_barrier_post(unsigned* bar, volatile LAS unsigned* st) {
    XcdBarrier b; b.bar = bar; b.x = xb_xcc_id(); b.st = st;
    if (threadIdx.x == 0) (void)xb_add(&bar[XB_XCNT(b.x)], 1u);
    return b;
}
__device__ __forceinline__ void xcd_barrier_complete(unsigned* bar, unsigned x, unsigned& nloc, unsigned& nx) {
    const unsigned G = gridDim.x * gridDim.y * gridDim.z;
    unsigned sum, cnt, mine, sp = 0u;
    for (;;) {
        sum = 0u; cnt = 0u; mine = 0u;
#pragma unroll
        for (unsigned j = 0; j < 16; ++j) { const unsigned c = xb_ld(&bar[XB_XCNT(j)]); sum += c; cnt += (c > 0u) ? 1u : 0u; mine = (j == x) ? c : mine; }
        if (sum == G) break;
        __builtin_amdgcn_s_sleep(1);
        if ((++sp & 255u) == 0u) { if (xb_ld(&bar[XB_TMO])) break; if (sp > XB_SPIN_CAP) { atomicAdd(&bar[XB_TMO], 1u); break; } }
    }
    nloc = mine > 0u ? mine : 1u; nx = cnt > 0u ? cnt : 1u;
}

__device__ __forceinline__ void xcd_barrier(const XcdBarrier& b) {
    asm volatile("s_waitcnt vmcnt(0)" ::: "memory");
    __syncthreads();
    if (threadIdx.x == 0) {
        unsigned* bar = b.bar;
        __builtin_amdgcn_s_waitcnt(0);
        unsigned nloc = b.st[0], nx = b.st[1];
        if (nloc == 0u) { xcd_barrier_complete(bar, b.x, nloc, nx); b.st[0] = nloc; b.st[1] = nx; }
        const unsigned old = xb_add(&bar[XB_XSUB(b.x)], 1u);
        const unsigned gen = old / nloc;
        if (old + 1u == (gen + 1u) * nloc) {
            __builtin_amdgcn_fence(__ATOMIC_RELEASE, "agent");
            asm volatile("s_waitcnt vmcnt(0)" ::: "memory");
            const unsigned og = xb_add(&bar[XB_TOP], 1u);
            const unsigned tg = og / nx;
            if (og + 1u == (tg + 1u) * nx) xb_add(&bar[XB_TOPGEN], 1u);
            else XB_SPIN(xb_ld(&bar[XB_TOPGEN]) == tg, bar);
            __builtin_amdgcn_fence(__ATOMIC_ACQUIRE, "agent");
            xb_add(&bar[XB_XGEN(b.x)], 1u);
            asm volatile("s_waitcnt vmcnt(0)" ::: "memory");
        } else {
            XB_SPIN(xb_ld(&bar[XB_XGEN(b.x)]) == gen, bar);
            __builtin_amdgcn_fence(__ATOMIC_ACQUIRE, "agent");
            asm volatile("s_waitcnt vmcnt(0)" ::: "memory");
        }
    }
    __syncthreads();
}


__global__ void __launch_bounds__(512, 2) mega(Params KP) {
    extern __shared__ __attribute__((aligned(16))) unsigned char lds_raw[];
    LAS unsigned char* lds = (LAS unsigned char*)lds_raw;
    cg::grid_group grid = cg::this_grid();
    const int G = gridDim.x;
    const int lo = KP.ph_lo, hi = KP.ph_hi;
    if (threadIdx.x == 0) { LAS unsigned long long* tab = (LAS unsigned long long*)(lds + PTAB_OFF);
#pragma unroll
        for (int i = 0; i < 28; ++i) tab[i] = (unsigned long long)KP.in[i]; }
    __syncthreads();
    volatile LAS unsigned* bst = (volatile LAS unsigned*)(lds + PTAB_OFF + 240);
    if (threadIdx.x < 2) bst[threadIdx.x] = 0u;
    __syncthreads();
    Ctx P; P.pt = (LAS const unsigned long long*)(lds + PTAB_OFF); P.out = KP.out; P.ws = KP.ws;
    const XcdBarrier xbar = xcd_barrier_post((unsigned*)(KP.ws + WS_BAR), bst);
    int ph = 0;
#ifndef PHASE_MASK
#define PHASE_MASK 0x3ff
#endif
#define PM(k) ((PHASE_MASK >> (k)) & 1)
#ifndef P3SEL
#define P3SEL 0xf
#endif
#define P3S(k) ((P3SEL >> (k)) & 1)
#ifndef REP1
#define REP1 1
#endif
#ifndef REP2
#define REP2 1
#endif
#ifndef REP3
#define REP3 1
#endif
#ifndef REP6
#define REP6 1
#endif
#ifndef REP7
#define REP7 1
#endif
#define RUN() (ph >= lo && ph < hi)
#define GSYNC() xcd_barrier(xbar)
#define SEAM() do { if (ph >= lo && ph + 1 < hi) GSYNC(); ++ph; } while (0)
#define PHASE_LOCALS() unsigned char* ws = opaque_ptr(P.ws); const int bid = opaque_bid(); (void)ws; (void)bid
#define WAVE_LOCALS() const int tid = opaque_tid(), lane = tid & 63, w = __builtin_amdgcn_readfirstlane(tid >> 6); (void)lane; (void)w

    if (PM(0) && RUN()) phase0(P, lds);
    if (ph >= lo && ph + 1 < hi) grid.sync();
    ++ph;
    for (int l = 0; l < DEPTH; ++l) {
        if (PM(1) && RUN()) for (int rep = 0; rep < REP1; ++rep) { if (rep) GSYNC(); PHASE_LOCALS(); pg8::Gemm g{(const bf16_t*)(ws + WS_XB), (const bf16_t*)(ws + WS_WIN) + (size_t)l * NZ * D, MM, 7168, D}; pg8::StaticOrder S; S.init(MM, 7168, G, bid);
            EpiScale E{(bf16_t*)(ws + WS_Z), NZ, (const float*)(ws + WS_SS)};
            int np = 2; asm volatile("" : "+s"(np));
            for (int pass = 0; pass < np; ++pass) {
                if ((pass == 0) == ((bid & 1) != 0)) {
                    tail_splitk<4, 4>(lds, g.A, g.Bt, D, MM, 4, 0, 112, 0, E);
                    tail_splitk<8, 1>(lds, g.A, g.Bt, D, 0, M / 128, ZC_GLR, 1, 192, E); }
                else pg8::gemm_phase<EpiScale>(lds, g, S, E); } }
        SEAM();
        if (PM(2) && RUN()) for (int rep = 0; rep < REP2; ++rep) { if (rep) GSYNC(); PHASE_LOCALS(); WAVE_LOCALS();
            LAS unsigned char* wl = lds + w * 16384;
            const int nitems = 4224 + 2112 + 4224, first = bid * 8 + w, stride = G * 8, cnt = first < nitems ? (nitems - 1 - first) / stride + 1 : 0;
            for (int k = 0; k < cnt; ++k) { const int it = first + ((w & 1) ? cnt - 1 - k : k) * stride;
                if (it < 4224) rg_prompt_item(P, l, it, wl, lane);
                else if (it < 6336) gla_qk_item(P, l, it - 4224, wl, lane);
                else gla_vt_item(P, it - 6336, lane);
            }
        }
        SEAM();
        if (PM(3) && RUN()) for (int rep = 0; rep < REP3; ++rep) { if (rep) GSYNC(); PHASE_LOCALS(); WAVE_LOCALS();
            LAS unsigned char* wl = lds + w * 16384;
            if (bid < 64) { if (P3S(0)) gla_prompt_unit(P, l, bid >> 3, (bid >> 1) & 3, bid & 1, lds); }
            else {
                for (int it = bid - 64; it < 528 + 16 + 512; it += G - 64) {
                    if (it < 528) { if (P3S(1)) rg_fix_item(P, l, it * 8 + w, lane); }
                    else if (it < 544) { if (P3S(2)) rg_sample_item(P, l, (it - 528) * 8 + w, wl, lane); }
                    else { if (P3S(3)) { __syncthreads(); gla_sample_item(P, l, (it - 544) >> 2, (it - 544) & 3, lds); } }
                }
                if (l + 1 < DEPTH) { __syncthreads(); prep_weights(P, lds, l + 1, (bid - 64) * 8 + w, (G - 64) * 8); }
            }
        }
        SEAM();
        if (PM(4) && RUN()) {
            gla_finalize(P, l);
            { PHASE_LOCALS(); pg8::StaticOrder S; S.init(MM, D, G, bid);
              pg8::Gemm g{(const bf16_t*)(ws + WS_HG), (const bf16_t*)(ws + WS_WA) + (size_t)l * D * D, MM, D, D}; EpiYa E{(bf16_t*)(ws + WS_T), (const bf16_t*)(ws + WS_Z)}; { int np = 2; asm volatile("" : "+s"(np)); for (int pass = 0; pass < np; ++pass) { if ((pass == 0) == ((bid & 1) != 0)) tail_splitk<2, 4>(lds, g.A, g.Bt, D, MM, 8, 0, 16, 0, E); else pg8::gemm_phase<EpiYa>(lds, g, S, E); } } }
            GSYNC();
            { PHASE_LOCALS(); pg8::StaticOrder S; S.init(MM, D, G, bid);
              pg8::Gemm g{(const bf16_t*)(ws + WS_OG), (const bf16_t*)(ws + WS_WB) + (size_t)l * D * D, MM, D, D}; EpiMerge E{(const bf16_t*)(ws + WS_T), (const bf16_t*)(ws + WS_Z), (bf16_t*)(ws + WS_MG)}; { int np = 2; asm volatile("" : "+s"(np)); for (int pass = 0; pass < np; ++pass) { if ((pass == 0) == ((bid & 1) != 0)) tail_splitk<2, 4>(lds, g.A, g.Bt, D, MM, 8, 0, 16, 0, E); else pg8::gemm_phase<EpiMerge>(lds, g, S, E); } } } }
        SEAM();
        if (PM(5) && RUN()) { PHASE_LOCALS(); pg8::Gemm g{(const bf16_t*)(ws + WS_MG), (const bf16_t*)(ws + WS_WO) + (size_t)l * D * D, MM, D, D}; pg8::StaticOrder S; S.init(MM, D, G, bid);
            EpiResid E{(bf16_t*)(ws + WS_XB), (float*)(ws + WS_SS) + (size_t)M * 16}; { int np = 2; asm volatile("" : "+s"(np)); for (int pass = 0; pass < np; ++pass) { if ((pass == 0) == ((bid & 1) != 0)) tail_splitk<2, 4>(lds, g.A, g.Bt, D, MM, 8, 0, 16, 0, E); else pg8::gemm_phase<EpiResid>(lds, g, S, E); } } }
        SEAM();
        if (PM(6) && RUN()) for (int rep = 0; rep < REP6; ++rep) { if (rep) GSYNC(); PHASE_LOCALS(); pg8::Gemm g{(const bf16_t*)(ws + WS_XB), (const bf16_t*)(ws + WS_WUP) + (size_t)l * DUP * D, MM, DUP, D}; pg8::StaticOrder S; S.init(MM, DUP, G, bid);
            EpiScale E{(bf16_t*)(ws + WS_U), DUP, (const float*)(ws + WS_SS) + (size_t)M * 16};
            int np = 2; asm volatile("" : "+s"(np));
            for (int pass = 0; pass < np; ++pass) {
                if ((pass == 0) == ((bid & 1) != 0)) tail_splitk<4, 4>(lds, g.A, g.Bt, D, MM, 4, 0, 96, 0, E);
                else pg8::gemm_phase<EpiScale>(lds, g, S, E); } }
        SEAM();
        if (PM(7) && RUN()) for (int rep = 0; rep < REP7; ++rep) { if (rep) GSYNC(); phase_geglu(P, l); }
        SEAM();
        if (PM(8) && RUN()) { PHASE_LOCALS(); pg8::Gemm g{(const bf16_t*)(ws + WS_ACT), (const bf16_t*)(ws + WS_WDN) + (size_t)l * D * DFF, MM, D, DFF}; pg8::StaticOrder S; S.init(MM, D, G, bid);
            EpiResid E{(bf16_t*)(ws + WS_XB), (float*)(ws + WS_SS)}; { int np = 2; asm volatile("" : "+s"(np)); for (int pass = 0; pass < np; ++pass) { if ((pass == 0) == ((bid & 1) != 0)) tail_splitk<2, 4>(lds, g.A, g.Bt, DFF, MM, 8, 0, 16, 0, E); else pg8::gemm_phase<EpiResid>(lds, g, S, E); } } }
        SEAM();
    }
    if (PM(9) && RUN()) { PHASE_LOCALS(); WAVE_LOCALS();
        const float* p_gf = INP(P, 27); const bf16_t* XBf = (const bf16_t*)(ws + WS_XB); const float* ss1 = (const float*)(ws + WS_SS);
        for (int row = bid * 8 + w; row < M; row += G * 8) {
            float* dst;
            if (row < MP) { const int b = row / TP, t = row % TP; if (t < 16) continue; dst = P.out + O_YP + ((size_t)b * 2048 + (t - 16)) * D; }
            else dst = P.out + O_YS + (size_t)(row - MP) * D;
            const float rs = rsqrtf(ss_total(ss1, row) * (1.f / 1024.f) + EPS);
#pragma unroll
            for (int j = 0; j < 4; ++j) { const u32x2 xw = *(const u32x2*)(XBf + (size_t)row * D + j * 256 + lane * 4); const f32x4 v = {bflo(xw.x), bfhi(xw.x), bflo(xw.y), bfhi(xw.y)}; const f32x4 gf = *(const f32x4*)(p_gf + j * 256 + lane * 4);
                *(f32x4*)(dst + j * 256 + lane * 4) = v * rs * gf; }
        }
    }
#undef RUN
#undef SEAM
}

extern "C" void kernel_launch(void* const* d_in, const int* in_sizes, int n_in, void* d_out, int out_size, void* d_ws, size_t ws_size, hipStream_t stream) {
    static int grid = 0;
    if (grid == 0) {
        int dev = 0, cus = 0, per_cu = 0;
        if (n_in != 28 || ws_size < WS_END) { fprintf(stderr, "kernel_launch: unexpected n_in %d / ws_size %zu (need %zu)\n", n_in, ws_size, (size_t)WS_END); grid = -1; return; }
        hipGetDevice(&dev);
        hipDeviceGetAttribute(&cus, hipDeviceAttributeMultiprocessorCount, dev);
        if (hipFuncSetAttribute((const void*)mega, hipFuncAttributeMaxDynamicSharedMemorySize, LDS_BYTES) != hipSuccess) { fprintf(stderr, "kernel_launch: hipFuncSetAttribute failed\n"); grid = -1; return; }
        if (hipOccupancyMaxActiveBlocksPerMultiprocessor(&per_cu, (const void*)mega, 512, LDS_BYTES) != hipSuccess || per_cu < 1) { fprintf(stderr, "kernel_launch: occupancy query gave %d\n", per_cu); per_cu = 1; }
        (void)hipGetLastError();
        grid = cus * per_cu;
    }
    if (grid < 0) return;
    if (hipMemsetAsync((char*)d_ws + WS_BAR, 0, 16384, stream) != hipSuccess) { fprintf(stderr, "kernel_launch: memset of the barrier words failed\n"); return; }
    Params p{};
    for (int i = 0; i < 28; ++i) p.in[i] = (const float*)d_in[i];
    p.out = (float*)d_out; p.ws = (unsigned char*)d_ws; p.ph_lo = 0; p.ph_hi = 1000;
    void* args[] = {&p};
    hipError_t e = hipLaunchCooperativeKernel((const void*)mega, dim3(grid), dim3(512), args, LDS_BYTES, stream);
    if (e != hipSuccess) fprintf(stderr, "cooperative launch failed: %s (grid %d)\n", hipGetErrorString(e), grid);
}
```

```cpp
#include <hip/hip_runtime.h>
#include <hip/hip_cooperative_groups.h>
#include <cstdio>
#include <cstdint>
namespace cg = cooperative_groups;

#define LAS __attribute__((address_space(3)))
typedef unsigned short bf16_t;
typedef short bf16x8 __attribute__((ext_vector_type(8)));
typedef float f32x4 __attribute__((ext_vector_type(4)));
typedef float f32x2 __attribute__((ext_vector_type(2)));
typedef unsigned u32x4 __attribute__((ext_vector_type(4)));
typedef unsigned u32x2 __attribute__((ext_vector_type(2)));
typedef __bf16 bf16x2_t __attribute__((ext_vector_type(2)));

constexpr int D = 1024, NB = 8, TP = 2064, DEPTH = 4, NS = 128, NCH = 33;
constexpr int MP = NB * TP;
constexpr int M = MP + NS;
constexpr int MM = 16384;
constexpr int NZ = 7424;
constexpr int DFF = 3072, DUP = 6144;
constexpr int ZC_RGX = 0, ZC_RGY = 1024, ZC_Q = 2048, ZC_K = 2560, ZC_V = 3072, ZC_GOUT = 4096, ZC_MA = 5120, ZC_MB = 6144, ZC_GLR = 7168;
constexpr float EPS = 1e-6f;

constexpr size_t O_YP = 0, O_YS = 16777216, O_RCP = O_YS + 131072, O_RHP = O_RCP + 98304, O_GP = O_RHP + 32768, O_FCP = O_GP + 4194304,
                 O_RCS = O_FCP + 393216, O_RHS = O_RCS + 1572864, O_GS = O_RHS + 524288, O_FCS = O_GS + 67108864;

constexpr size_t al256(size_t x) { return (x + 255) & ~(size_t)255; }
constexpr size_t WS_WIN = 0;
constexpr size_t WS_WA = WS_WIN + (size_t)DEPTH * NZ * D * 2;
constexpr size_t WS_WB = WS_WA + (size_t)DEPTH * D * D * 2;
constexpr size_t WS_WO = WS_WB + (size_t)DEPTH * D * D * 2;
constexpr size_t WS_WUP = WS_WO + (size_t)DEPTH * D * D * 2;
constexpr size_t WS_WDN = WS_WUP + (size_t)DEPTH * DUP * D * 2;
constexpr size_t WS_RGW = WS_WDN + (size_t)DEPTH * D * DFF * 2;
constexpr size_t WS_XF = WS_RGW + (size_t)DEPTH * 2 * 16 * 64 * 64 * 2;
constexpr size_t WS_XB = WS_XF + (size_t)M * D * 4;
constexpr size_t WS_Z = WS_XB + (size_t)M * D * 2;
constexpr size_t WS_U = WS_Z;
constexpr size_t WS_HG = WS_Z + (size_t)M * NZ * 2;
constexpr size_t WS_OG = WS_HG + (size_t)M * D * 2;
constexpr size_t WS_MG = WS_OG + (size_t)M * D * 2;
constexpr size_t WS_ACT = WS_HG;
constexpr size_t WS_T = WS_MG + (size_t)M * D * 2;
constexpr size_t WS_QD = WS_T + (size_t)M * D * 4;
constexpr size_t CHT = (size_t)NB * NCH * 4 * 64 * 128;
constexpr size_t WS_KD = WS_QD + CHT * 2;
constexpr size_t WS_KET = WS_KD + CHT * 2;
constexpr size_t WS_VT = WS_KET + CHT * 2;
constexpr size_t WS_DEC = WS_VT + CHT * 4;
constexpr size_t WS_CARRY = WS_DEC + (size_t)NB * NCH * 512 * 4;
constexpr size_t WS_SS = WS_CARRY + (size_t)NB * NCH * 1024 * 2 * 4;
constexpr size_t WS_GSS = al256(WS_SS + (size_t)2 * M * 16 * 4);
constexpr size_t WS_BAR = al256(WS_GSS + (size_t)MP * 4 * 16 * 4);
constexpr size_t WS_END = al256(WS_BAR + 16384);
static_assert(WS_END < 1000000000ull, "workspace map");

constexpr int LDS_BYTES = 163840;

struct Params { const float* in[28]; float* out; unsigned char* ws; int ph_lo, ph_hi; };
constexpr int PTAB_OFF = 163328;
struct Ctx { LAS const unsigned long long* pt; float* out; unsigned char* ws; };
__device__ __forceinline__ const float* INP(const Ctx& X, int i) { const unsigned long long v = X.pt[i];
    const unsigned lo = __builtin_amdgcn_readfirstlane((unsigned)v), hi = __builtin_amdgcn_readfirstlane((unsigned)(v >> 32)); return (const float*)(((unsigned long long)hi << 32) | lo); }

__device__ __forceinline__ float bf2f(unsigned b) { return __uint_as_float(b << 16); }
__device__ __forceinline__ float bflo(unsigned w) { return __uint_as_float(w << 16); }
__device__ __forceinline__ float bfhi(unsigned w) { return __uint_as_float(w & 0xffff0000u); }
__device__ __forceinline__ unsigned pk2(float lo, float hi) { f32x2 v = {lo, hi}; bf16x2_t b = __builtin_convertvector(v, bf16x2_t); return __builtin_bit_cast(unsigned, b); }
__device__ __forceinline__ bf16_t f2bf(float f) { return (bf16_t)(pk2(f, 0.f) & 0xffffu); }
__device__ __forceinline__ float ss_total(const float* ss, int row) { const f32x4* sp = (const f32x4*)(ss + (size_t)row * 16); const f32x4 a = sp[0], b = sp[1], c = sp[2], d = sp[3];
    return (((a[0] + a[1]) + (a[2] + a[3])) + ((b[0] + b[1]) + (b[2] + b[3]))) + (((c[0] + c[1]) + (c[2] + c[3])) + ((d[0] + d[1]) + (d[2] + d[3]))); }
__device__ __forceinline__ float sigm(float x) { return __builtin_amdgcn_rcpf(1.f + __expf(-x)); }
__device__ __forceinline__ float softplus_(float x) { return fmaxf(x, 0.f) + __logf(1.f + __expf(-fabsf(x))); }
__device__ __forceinline__ float gelu_t(float x) { const float u = 0.7978845608028654f * (x + 0.044715f * x * x * x); return x * sigm(2.f * u); }
__device__ __forceinline__ float silu_(float x) { return x * sigm(x); }
__device__ __forceinline__ int opaque_tid() { int t = threadIdx.x; asm volatile("" : "+v"(t)); return t; }
__device__ __forceinline__ int opaque_bid() { int b = blockIdx.x; asm volatile("" : "+s"(b)); return b; }
__device__ __forceinline__ unsigned char* opaque_ptr(unsigned char* p) { asm volatile("" : "+s"(p)); return p; }
#define LDS_BARRIER() do { asm volatile("s_waitcnt lgkmcnt(0)" ::: "memory"); __builtin_amdgcn_s_barrier(); asm volatile("" ::: "memory"); } while (0)
#define WAVE_LDS_FENCE() asm volatile("s_waitcnt lgkmcnt(0)" ::: "memory")
#define MFMA16(a, b, c) __builtin_amdgcn_mfma_f32_16x16x32_bf16((a), (b), (c), 0, 0, 0)

namespace pg8 {
constexpr int BM = 256, BK = 64, HALF = 128, HTB = HALF * BK * 2, STAGE_BYTES = 8 * HTB, NXCD = 8, WGM = 8;
__host__ __device__ __forceinline__ int lds_byte(int r, int c) { const int st = (r >> 4) * 2 + (c >> 5), rr = r & 15, cc = c & 31, ob = rr * 64 + cc * 2; return st * 1024 + (ob ^ (((ob >> 9) & 1) << 5)); }
__host__ __device__ __forceinline__ void stage_rc(int b, int& R, int& C) { const int st = b / 1024, sb = b % 1024, swz = sb ^ (((sb >> 9) & 1) << 5); R = (st >> 1) * 16 + swz / 64; C = (st & 1) * 32 + (swz % 64) / 2; }
__host__ __device__ __forceinline__ int perm32(int rho) { const int n = rho >> 4, i = rho & 15; return 8 * (i >> 2) + 4 * n + (i & 3); }
struct Unit { int pm, pn; };
struct Gemm { const bf16_t* A; const bf16_t* Bt; int M, N, K; };
struct StaticOrder {
    int nM, nN, nwg, G, c;
    __device__ void init(int M_, int N_, int G_, int c_) { nM = M_ / BM; nN = N_ / BM; nwg = nM * nN; G = G_; c = c_; }
    __device__ bool next(int i, Unit& u) const {
        const long L = (long)i * G + c; if (L >= nwg) return false;
        int wgid = (int)L; { const int q = nwg / NXCD, r = nwg % NXCD, xcd = wgid % NXCD, off = wgid / NXCD; wgid = (xcd < r ? xcd * (q + 1) : r * (q + 1) + (xcd - r) * q) + off; }
        const int nig = WGM * nN, gid = wgid / nig, fm = gid * WGM, gsz = (nM - fm) < WGM ? (nM - fm) : WGM;
        u.pm = fm + ((wgid % nig) % gsz); u.pn = (wgid % nig) / gsz; return true;
    }
};
template <class Epi>
__device__ __forceinline__ void gemm_phase(LAS unsigned char* lds, const Gemm g, const StaticOrder& S, const Epi& E) {
    const int tid = opaque_tid(), wid = __builtin_amdgcn_readfirstlane(tid >> 6), lane = tid & 63, wr = wid >> 2, wc = wid & 3, fr = lane & 15, fq = lane >> 4;
    const int K = g.K, nt = K / BK;
    unsigned voffA[2], voffB[2];
#pragma unroll
    for (int i = 0; i < 2; ++i) { int R, C; stage_rc(tid * 16 + i * 8192, R, C); const int Rb = Epi::PERM ? ((R & ~31) + perm32(R & 31)) : R;
        voffA[i] = (unsigned)(R * K + C) * 2u; voffB[i] = (unsigned)(Rb * K + C) * 2u; }
    const size_t kstep = (size_t)(BK * 2);
    const size_t hstep = (size_t)HALF * K * 2;
    const size_t tstep = 2 * hstep;
    const unsigned ldsw = (unsigned)wid * 1024u;
    const int aoff = lds_byte(wr * 64 + fr, fq * 8), boff = lds_byte(wc * 32 + fr, fq * 8);
#define PG8_SA(b, h) (((b) * 2 + (h)) * HTB)
#define PG8_SB(b, h) ((4 + (b) * 2 + (h)) * HTB)
#define PG8_STAGE(bufoff, gbase, voff) do { _Pragma("unroll") for (int _i = 0; _i < 2; ++_i) \
        __builtin_amdgcn_global_load_lds((const unsigned*)((const char*)(gbase) + (voff)[_i]), (LAS unsigned*)(lds + (bufoff) + ldsw + _i * 8192), 16, 0, 0); } while (0)
#define PG8_LDA(dst, b, h) do { _Pragma("unroll") for (int m = 0; m < 4; ++m) _Pragma("unroll") for (int k = 0; k < 2; ++k) dst[m][k] = *(const LAS bf16x8*)(lds + PG8_SA(b, h) + aoff + m * 2048 + k * 1024); } while (0)
#define PG8_LDB(dst, b, h) do { _Pragma("unroll") for (int n = 0; n < 2; ++n) _Pragma("unroll") for (int k = 0; k < 2; ++k) dst[n][k] = *(const LAS bf16x8*)(lds + PG8_SB(b, h) + boff + n * 2048 + k * 1024); } while (0)
#define PG8_MMA(ai, bj, At, Bt) do { __builtin_amdgcn_s_setprio(1); _Pragma("unroll") for (int m = 0; m < 4; ++m) _Pragma("unroll") for (int n = 0; n < 2; ++n) _Pragma("unroll") for (int k = 0; k < 2; ++k) \
        acc[ai][bj][m][n] = __builtin_amdgcn_mfma_f32_16x16x32_bf16(Bt[n][k], At[m][k], acc[ai][bj][m][n], 0, 0, 0); __builtin_amdgcn_s_setprio(0); } while (0)
#define PG8_WAIT_V(n) asm volatile("s_waitcnt vmcnt(" #n ")" ::: "memory")
#define PG8_WAIT_L(n) asm volatile("s_waitcnt lgkmcnt(" #n ")" ::: "memory")
#define PG8_BAR __builtin_amdgcn_s_barrier()
#define PG8_SCHED __builtin_amdgcn_sched_barrier(0)
    Unit cur, nxt; int ui = 0;
    if (!S.next(0, cur)) return;
    f32x4 acc[2][2][4][2];
#pragma unroll
    for (int a = 0; a < 2; ++a)
#pragma unroll
        for (int b = 0; b < 2; ++b)
#pragma unroll
            for (int m = 0; m < 4; ++m)
#pragma unroll
                for (int n = 0; n < 2; ++n) acc[a][b][m][n] = (f32x4){0.f, 0.f, 0.f, 0.f};
    bf16x8 At[4][2], B0[2][2], B1[2][2];
    const char* cA = (const char*)g.A + (size_t)cur.pm * tstep; const char* cB = (const char*)g.Bt + (size_t)cur.pn * tstep;
    PG8_STAGE(PG8_SB(0, 0), cB, voffB); PG8_STAGE(PG8_SB(0, 1), cB + hstep, voffB); PG8_STAGE(PG8_SA(0, 0), cA, voffA); PG8_STAGE(PG8_SA(0, 1), cA + hstep, voffA);
    if (wr == 1) PG8_BAR;
    PG8_WAIT_V(2); PG8_BAR;
    PG8_STAGE(PG8_SB(1, 0), cB + kstep, voffB); PG8_STAGE(PG8_SA(1, 0), cA + kstep, voffA); PG8_STAGE(PG8_SB(1, 1), cB + hstep + kstep, voffB);
    PG8_WAIT_V(6); PG8_BAR;
    for (;;) {
        const bool has_next = S.next(ui + 1, nxt);
        const char* nA = has_next ? (const char*)g.A + (size_t)nxt.pm * tstep : cA; const char* nB = has_next ? (const char*)g.Bt + (size_t)nxt.pn * tstep : cB;
        for (int t = 0; t < nt; t += 2) {
            const bool last = (t == nt - 2);
            const char* a1 = cA + (size_t)(t + 1) * kstep;
            const char* a2 = last ? nA : cA + (size_t)(t + 2) * kstep; const char* b2 = last ? nB : cB + (size_t)(t + 2) * kstep;
            const char* a3 = a2 + kstep; const char* b3 = b2 + kstep;
            PG8_LDB(B0, 0, 0); PG8_LDB(B1, 0, 1); PG8_SCHED; PG8_LDA(At, 0, 0); PG8_STAGE(PG8_SA(1, 1), a1 + hstep, voffA);
            PG8_WAIT_V(8); PG8_WAIT_L(0); PG8_BAR; PG8_MMA(0, 0, At, B0); PG8_MMA(0, 1, At, B1); PG8_BAR; PG8_SCHED;
            PG8_LDA(At, 0, 1); PG8_STAGE(PG8_SB(0, 0), b2, voffB); PG8_STAGE(PG8_SB(0, 1), b2 + hstep, voffB); PG8_STAGE(PG8_SA(0, 0), a2, voffA);
            PG8_WAIT_V(8); PG8_WAIT_L(0); PG8_BAR; PG8_MMA(1, 0, At, B0); PG8_MMA(1, 1, At, B1); PG8_BAR; PG8_SCHED;
            PG8_LDB(B0, 1, 0); PG8_LDB(B1, 1, 1); PG8_SCHED; PG8_LDA(At, 1, 0); PG8_STAGE(PG8_SA(0, 1), a2 + hstep, voffA);
            PG8_WAIT_V(8); PG8_WAIT_L(0); PG8_BAR; PG8_MMA(0, 0, At, B0); PG8_MMA(0, 1, At, B1); PG8_BAR; PG8_SCHED;
            PG8_LDA(At, 1, 1); PG8_STAGE(PG8_SB(1, 0), b3, voffB); PG8_STAGE(PG8_SB(1, 1), b3 + hstep, voffB); PG8_STAGE(PG8_SA(1, 0), a3, voffA);
            PG8_WAIT_V(8); PG8_WAIT_L(0); PG8_BAR; PG8_MMA(1, 0, At, B0); PG8_MMA(1, 1, At, B1); PG8_BAR; PG8_SCHED;
        }
        if (wr == 0) PG8_BAR;
        E(acc, cur, wr, wc, fr, fq);
        if (!has_next) break;
#pragma unroll
        for (int a = 0; a < 2; ++a)
#pragma unroll
            for (int b = 0; b < 2; ++b)
#pragma unroll
                for (int m = 0; m < 4; ++m)
#pragma unroll
                    for (int n = 0; n < 2; ++n) acc[a][b][m][n] = (f32x4){0.f, 0.f, 0.f, 0.f};
        cur = nxt; cA = nA; cB = nB; ++ui;
        if (wr == 1) PG8_BAR;
    }
    PG8_WAIT_V(0);
    PG8_BAR;
#undef PG8_SA
#undef PG8_SB
#undef PG8_STAGE
#undef PG8_LDA
#undef PG8_LDB
#undef PG8_MMA
#undef PG8_WAIT_V
#undef PG8_WAIT_L
#undef PG8_BAR
#undef PG8_SCHED
}
}

struct EpiScale {
    static constexpr bool PERM = true;
    bf16_t* O; int ldc; const float* ss;
    __device__ __forceinline__ void operator()(const f32x4 (&acc)[2][2][4][2], const pg8::Unit& u, int wr, int wc, int fr, int fq) const {
        const int row0 = u.pm * 256 + wr * 64 + fr, col0 = u.pn * 256 + wc * 32 + 8 * fq;
#pragma unroll
        for (int ai = 0; ai < 2; ++ai)
#pragma unroll
            for (int m = 0; m < 4; ++m) { const int row = row0 + ai * 128 + m * 16; const float rs = rsqrtf(ss_total(ss, row) * (1.f / 1024.f) + EPS);
                bf16_t* rowp = O + (size_t)row * ldc + col0;
#pragma unroll
                for (int bj = 0; bj < 2; ++bj) { const f32x4 v0 = acc[ai][bj][m][0] * rs, v1 = acc[ai][bj][m][1] * rs;
                    u32x4 w; w.x = pk2(v0[0], v0[1]); w.y = pk2(v0[2], v0[3]); w.z = pk2(v1[0], v1[1]); w.w = pk2(v1[2], v1[3]);
                    *(u32x4*)(rowp + bj * 128) = w; } }
    }
    template <int QPR> __device__ __forceinline__ void tailq(int row, int c, f32x4 v, int) const {
        const float rs = rsqrtf(ss_total(ss, row) * (1.f / 1024.f) + EPS); v = v * rs;
        u32x2 w; w.x = pk2(v[0], v[1]); w.y = pk2(v[2], v[3]); *(u32x2*)(O + (size_t)row * ldc + c) = w; }
};
struct EpiYa {
    static constexpr bool PERM = false;
    bf16_t* T; const bf16_t* Z;
    __device__ __forceinline__ void quad(int row, int c, f32x4 v) const {
        const u32x2 gw = *(const u32x2*)(Z + (size_t)row * NZ + ZC_MA + c);
        v[0] *= sigm(bflo(gw.x)); v[1] *= sigm(bfhi(gw.x)); v[2] *= sigm(bflo(gw.y)); v[3] *= sigm(bfhi(gw.y));
        u32x2 w; w.x = pk2(v[0], v[1]); w.y = pk2(v[2], v[3]); *(u32x2*)(T + (size_t)row * D + c) = w; }
    template <int QPR> __device__ __forceinline__ void tailq(int row, int c, const f32x4 v, int) const { quad(row, c, v); }
    __device__ __forceinline__ void operator()(const f32x4 (&acc)[2][2][4][2], const pg8::Unit& u, int wr, int wc, int fr, int fq) const {
        const int row0 = u.pm * 256 + wr * 64 + fr, col0 = u.pn * 256 + wc * 32 + 4 * fq;
#pragma unroll
        for (int ai = 0; ai < 2; ++ai)
#pragma unroll
            for (int m = 0; m < 4; ++m) { const int row = row0 + ai * 128 + m * 16;
#pragma unroll
                for (int bj = 0; bj < 2; ++bj)
#pragma unroll
                    for (int n = 0; n < 2; ++n) { const int c = col0 + bj * 128 + n * 16;
                        quad(row, c, acc[ai][bj][m][n]); } }
    }
};
struct EpiMerge {
    static constexpr bool PERM = false;
    const bf16_t* T; const bf16_t* Z; bf16_t* MG;
    __device__ __forceinline__ void quad(int row, int c, const f32x4 a) const {
        const u32x2 gw = *(const u32x2*)(Z + (size_t)row * NZ + ZC_MB + c);
        const u32x2 tw = *(const u32x2*)(T + (size_t)row * D + c); const f32x4 t = {bflo(tw.x), bfhi(tw.x), bflo(tw.y), bfhi(tw.y)};
        const float v0 = t[0] + a[0] * sigm(bflo(gw.x)), v1 = t[1] + a[1] * sigm(bfhi(gw.x)), v2 = t[2] + a[2] * sigm(bflo(gw.y)), v3 = t[3] + a[3] * sigm(bfhi(gw.y));
        u32x2 w; w.x = pk2(v0, v1); w.y = pk2(v2, v3);
        *(u32x2*)(MG + (size_t)row * D + c) = w; }
    template <int QPR> __device__ __forceinline__ void tailq(int row, int c, const f32x4 v, int) const { quad(row, c, v); }
    __device__ __forceinline__ void operator()(const f32x4 (&acc)[2][2][4][2], const pg8::Unit& u, int wr, int wc, int fr, int fq) const {
        const int row0 = u.pm * 256 + wr * 64 + fr, col0 = u.pn * 256 + wc * 32 + 4 * fq;
#pragma unroll
        for (int ai = 0; ai < 2; ++ai)
#pragma unroll
            for (int m = 0; m < 4; ++m) { const int row = row0 + ai * 128 + m * 16;
#pragma unroll
                for (int bj = 0; bj < 2; ++bj)
#pragma unroll
                    for (int n = 0; n < 2; ++n) { const int c = col0 + bj * 128 + n * 16;
                        quad(row, c, acc[ai][bj][m][n]); } }
    }
};
struct EpiResid {
    static constexpr bool PERM = false;
    bf16_t* XB; float* ss;
    __device__ __forceinline__ float quad(int row, int c, const f32x4 a) const {
        bf16_t* xp = XB + (size_t)row * D + c;
        const u32x2 xw = *(const u32x2*)xp;
        const f32x4 x = (f32x4){bflo(xw.x), bfhi(xw.x), bflo(xw.y), bfhi(xw.y)} + a;
        u32x2 w; w.x = pk2(x[0], x[1]); w.y = pk2(x[2], x[3]);
        *(u32x2*)xp = w;
        return (x[0] * x[0] + x[1] * x[1]) + (x[2] * x[2] + x[3] * x[3]); }
    template <int QPR> __device__ __forceinline__ void tailq(int row, int c, const f32x4 v, int c0) const {
        float sq = quad(row, c, v);
#pragma unroll
        for (int o = 1; o < QPR; o <<= 1) sq += __shfl_xor(sq, o);
        if ((threadIdx.x & (QPR - 1)) == 0) ss[(size_t)row * 16 + (c0 >> 6)] = sq; }
    __device__ __forceinline__ void operator()(const f32x4 (&acc)[2][2][4][2], const pg8::Unit& u, int wr, int wc, int fr, int fq) const {
        const int row0 = u.pm * 256 + wr * 64 + fr, col0 = u.pn * 256 + wc * 32 + 4 * fq;
#pragma unroll
        for (int ai = 0; ai < 2; ++ai)
#pragma unroll
            for (int m = 0; m < 4; ++m) { const int row = row0 + ai * 128 + m * 16; float sq = 0.f;
#pragma unroll
                for (int bj = 0; bj < 2; ++bj)
#pragma unroll
                    for (int n = 0; n < 2; ++n) { const int c = col0 + bj * 128 + n * 16;
                        sq += quad(row, c, acc[ai][bj][m][n]); }
                sq += __shfl_xor(sq, 16); sq += __shfl_xor(sq, 32);
                if (fq == 0) ss[(size_t)row * 16 + u.pn * 4 + wc] = sq; }
    }
};

template <int MT, int NT, class Epi>
__device__ __forceinline__ void tail_splitk(LAS unsigned char* lds, const bf16_t* A, const bf16_t* Bt, int K, int row_base, int n_rt, int col_base, int n_ct, int it0, const Epi& E) {
    const int tid = opaque_tid(), lane = tid & 63, w = __builtin_amdgcn_readfirstlane(tid >> 6), fr = lane & 15, fq = lane >> 4, bid = opaque_bid(), G = gridDim.x;
    constexpr int RS = NT * 16 + 4, WB = MT * 16 * RS * 4, QPR = NT * 4;
    const int nks = K / 256;
    for (int it = (bid - it0 + G) % G; it < n_rt * n_ct; it += G) {
        const int rt = it % n_rt, ct = it / n_rt, r0 = row_base + rt * 16 * MT, c0 = col_base + ct * 16 * NT;
        f32x4 acc[MT][NT];
#pragma unroll
        for (int mt = 0; mt < MT; ++mt)
#pragma unroll
            for (int nt = 0; nt < NT; ++nt) acc[mt][nt] = (f32x4){0.f, 0.f, 0.f, 0.f};
        const bf16_t* ap = A + (size_t)(r0 + fr) * K + fq * 8 + w * nks * 32; const bf16_t* bp = Bt + (size_t)(c0 + fr) * K + fq * 8 + w * nks * 32;
#pragma unroll 4
        for (int ks = 0; ks < nks; ++ks) {
            bf16x8 af[MT], bfv[NT];
#pragma unroll
            for (int mt = 0; mt < MT; ++mt) af[mt] = *(const bf16x8*)(ap + (size_t)mt * 16 * K + ks * 32);
#pragma unroll
            for (int nt = 0; nt < NT; ++nt) bfv[nt] = *(const bf16x8*)(bp + (size_t)nt * 16 * K + ks * 32);
#pragma unroll
            for (int mt = 0; mt < MT; ++mt)
#pragma unroll
                for (int nt = 0; nt < NT; ++nt) acc[mt][nt] = MFMA16(bfv[nt], af[mt], acc[mt][nt]);
        }
        LAS float* pw = (LAS float*)(lds + w * WB);
#pragma unroll
        for (int mt = 0; mt < MT; ++mt)
#pragma unroll
            for (int nt = 0; nt < NT; ++nt) *(LAS f32x4*)(pw + (16 * mt + fr) * RS + 16 * nt + 4 * fq) = acc[mt][nt];
        LDS_BARRIER();
#pragma unroll
        for (int q = tid; q < MT * 16 * QPR; q += 512) { const int row = q / QPR, qc = q % QPR;
            f32x4 v = {0.f, 0.f, 0.f, 0.f};
#pragma unroll
            for (int ww = 0; ww < 8; ++ww) v = v + *(const LAS f32x4*)(lds + ww * WB + (row * RS + qc * 4) * 4);
            E.template tailq<QPR>(r0 + row, c0 + qc * 4, v, c0); }
        LDS_BARRIER();
    }
}

template <int MODE>
__device__ __forceinline__ void transpose_item(const float* W, int K, int Nsrc, const float* g, bf16_t* WT, LAS float* scr, int kb, int nb, int lane) {
    const int k0 = 64 * kb, n0 = 32 * nb, nd = n0 + (lane & 7) * 4;
    int src = nd;
    if (MODE == 1) src = nd < 4096 ? nd : (nd < 7168 ? nd + 16 : (nd < 7184 ? nd - 7168 + 4096 : -1));
#pragma unroll
    for (int i = 0; i < 8; ++i) { const int kk = 8 * i + (lane >> 3); f32x4 v = {0.f, 0.f, 0.f, 0.f};
        if (src >= 0) { v = *(const f32x4*)(W + (size_t)(k0 + kk) * Nsrc + src); if (g) v = v * g[k0 + kk]; }
        LAS float* d = scr + kk * 33 + (lane & 7) * 4; d[0] = v[0]; d[1] = v[1]; d[2] = v[2]; d[3] = v[3]; }
    WAVE_LDS_FENCE();
    const int c = lane & 7;
#pragma unroll
    for (int j = 0; j < 4; ++j) { const int n = (lane >> 3) + 8 * j; const LAS float* s = scr + (8 * c) * 33 + n;
        u32x4 o; o.x = pk2(s[0 * 33], s[1 * 33]); o.y = pk2(s[2 * 33], s[3 * 33]); o.z = pk2(s[4 * 33], s[5 * 33]); o.w = pk2(s[6 * 33], s[7 * 33]);
        *(u32x4*)(WT + (size_t)(n0 + n) * K + k0 + 8 * c) = o; }
    WAVE_LDS_FENCE();
}

__device__ __forceinline__ void prep_weights(const Ctx& P, LAS unsigned char* lds, int l, int gw, int NGW) {
    const int tid = opaque_tid(), lane = tid & 63, w = __builtin_amdgcn_readfirstlane(tid >> 6);
    LAS float* scr = (LAS float*)(lds + w * 16384);
    unsigned char* ws = P.ws;
    constexpr int I_IN = 16 * 232, I_SQ = 16 * 32, I_UP = 16 * 192, I_DN = 48 * 32, I_L = I_IN + 3 * I_SQ + I_UP + I_DN;
    const float* p_win = INP(P, 8); const float* p_g1 = INP(P, 7); const float* p_wa = INP(P, 19); const float* p_wb = INP(P, 20); const float* p_wo = INP(P, 21); const float* p_wup = INP(P, 23); const float* p_g2 = INP(P, 22); const float* p_wdn = INP(P, 26);
    for (int it = gw; it < I_L; it += NGW) {
        int r = it;
        if (r < I_IN) { transpose_item<1>(p_win + (size_t)l * D * 7184, D, 7184, p_g1 + l * D, (bf16_t*)(ws + WS_WIN) + (size_t)l * NZ * D, scr, r / 232, r % 232, lane); continue; } r -= I_IN;
        if (r < I_SQ) { transpose_item<0>(p_wa + (size_t)l * D * D, D, D, nullptr, (bf16_t*)(ws + WS_WA) + (size_t)l * D * D, scr, r / 32, r % 32, lane); continue; } r -= I_SQ;
        if (r < I_SQ) { transpose_item<0>(p_wb + (size_t)l * D * D, D, D, nullptr, (bf16_t*)(ws + WS_WB) + (size_t)l * D * D, scr, r / 32, r % 32, lane); continue; } r -= I_SQ;
        if (r < I_SQ) { transpose_item<0>(p_wo + (size_t)l * D * D, D, D, nullptr, (bf16_t*)(ws + WS_WO) + (size_t)l * D * D, scr, r / 32, r % 32, lane); continue; } r -= I_SQ;
        if (r < I_UP) { transpose_item<0>(p_wup + (size_t)l * D * DUP, D, DUP, p_g2 + l * D, (bf16_t*)(ws + WS_WUP) + (size_t)l * DUP * D, scr, r / 192, r % 192, lane); continue; } r -= I_UP;
        transpose_item<0>(p_wdn + (size_t)l * DFF * D, DFF, D, nullptr, (bf16_t*)(ws + WS_WDN) + (size_t)l * D * DFF, scr, r / 32, r % 32, lane);
    }
    { bf16_t* RGW = (bf16_t*)(ws + WS_RGW); const float* p_wx = INP(P, 13); const float* p_wa2 = INP(P, 11);
      for (int j = gw * 64 + lane; j < 2 * 16 * 64 * 64; j += NGW * 64) { const int i = l * (2 * 16 * 64 * 64) + j;
          const int c = i & 63, d = (i >> 6) & 63, blk = (i >> 12) & 15, g = (i >> 16) & 1;
          const float* src = (g ? p_wx : p_wa2) + (((size_t)l * 16 + blk) * 64 + c) * 64 + d;
          RGW[i] = f2bf(*src); } }
}
__device__ __forceinline__ void phase0(const Ctx& P, LAS unsigned char* lds) {
    const int tid = opaque_tid(), lane = tid & 63, w = __builtin_amdgcn_readfirstlane(tid >> 6), bid = opaque_bid();
    const int gw = bid * 8 + w, NGW = gridDim.x * 8;
    unsigned char* ws = P.ws;
    prep_weights(P, lds, 0, gw, NGW);
    bf16_t* XB = (bf16_t*)(ws + WS_XB); float* ss = (float*)(ws + WS_SS);
    const float* p_meta = INP(P, 6); const float* p_xp = INP(P, 0); const float* p_xs = INP(P, 1);
    for (int row = gw; row < M; row += NGW) {
        const float* src;
        if (row < MP) { const int b = row / TP, t = row % TP; src = t < 16 ? p_meta + (size_t)t * D : p_xp + ((size_t)b * 2048 + (t - 16)) * D; }
        else src = p_xs + (size_t)(row - MP) * D;
        float sq = 0.f;
#pragma unroll
        for (int j = 0; j < 4; ++j) { const f32x4 v = *(const f32x4*)(src + j * 256 + lane * 4);
            u32x2 o; o.x = pk2(v[0], v[1]); o.y = pk2(v[2], v[3]); *(u32x2*)(XB + (size_t)row * D + j * 256 + lane * 4) = o;
            sq += (v[0] * v[0] + v[1] * v[1]) + (v[2] * v[2] + v[3] * v[3]); }
#pragma unroll
        for (int o = 1; o < 64; o <<= 1) sq += __shfl_xor(sq, o);
        if (lane < 16) ss[(size_t)row * 16 + lane] = lane == 0 ? sq : 0.f;
    }
}

__device__ __forceinline__ void rg_gates16(LAS unsigned char* wl, const float (&xc)[16], const bf16x8 (&bw)[2][4][2], float ba, float bx, float sp8, int lane, float (&a)[16], float (&bb)[16]) {
    LAS bf16_t* XC = (LAS bf16_t*)wl;
    LAS float* PR = (LAS float*)(wl + 2304);
    const int fr = lane & 15, fq = lane >> 4;
#pragma unroll
    for (int i = 0; i < 16; ++i) XC[i * 72 + lane] = f2bf(xc[i]);
    WAVE_LDS_FENCE();
    bf16x8 af[2];
#pragma unroll
    for (int ks = 0; ks < 2; ++ks) af[ks] = *(const LAS bf16x8*)(wl + fr * 144 + ks * 64 + fq * 16);
#pragma unroll
    for (int g = 0; g < 2; ++g)
#pragma unroll
        for (int ct = 0; ct < 4; ++ct) { f32x4 acc = {0.f, 0.f, 0.f, 0.f};
#pragma unroll
            for (int ks = 0; ks < 2; ++ks) acc = MFMA16(af[ks], bw[g][ct][ks], acc);
#pragma unroll
            for (int j = 0; j < 4; ++j) PR[g * 16 * 68 + (fq * 4 + j) * 68 + 16 * ct + fr] = acc[j]; }
    WAVE_LDS_FENCE();
    float prr[16], pri[16];
#pragma unroll
    for (int i = 0; i < 16; ++i) { prr[i] = PR[i * 68 + lane]; pri[i] = PR[16 * 68 + i * 68 + lane]; }
    __builtin_amdgcn_sched_barrier(0);
#pragma unroll
    for (int i = 0; i < 16; ++i) { const float r = sigm(prr[i] + ba), ig = sigm(pri[i] + bx);
        const float la = -sp8 * r; const float av = __expf(la); a[i] = av; bb[i] = __builtin_amdgcn_sqrtf(fmaxf(1.f - av * av, 0.f)) * (ig * xc[i]); }
    WAVE_LDS_FENCE();
}
struct RgConst { float cw0, cw1, cw2, cw3, cb, ba, bx, sp8; };
__device__ __forceinline__ void rg_load_const(const Ctx& P, int l, int ch, int nb, int lane, RgConst& c, bf16x8 (&bw)[2][4][2]) {
    const float* p_cw = INP(P, 9);
    c.cw0 = p_cw[(size_t)(l * 4 + 0) * D + ch]; c.cw1 = p_cw[(size_t)(l * 4 + 1) * D + ch]; c.cw2 = p_cw[(size_t)(l * 4 + 2) * D + ch]; c.cw3 = p_cw[(size_t)(l * 4 + 3) * D + ch];
    c.cb = INP(P, 10)[l * D + ch]; c.ba = INP(P, 12)[l * D + ch]; c.bx = INP(P, 14)[l * D + ch]; c.sp8 = 8.f * softplus_(-INP(P, 15)[l * D + ch]);
    const bf16_t* RGW = (const bf16_t*)(P.ws + WS_RGW);
    const int fr = lane & 15, fq = lane >> 4;
#pragma unroll
    for (int g = 0; g < 2; ++g)
#pragma unroll
        for (int ct = 0; ct < 4; ++ct)
#pragma unroll
            for (int ks = 0; ks < 2; ++ks) bw[g][ct][ks] = *(const bf16x8*)(RGW + ((((size_t)l * 2 + g) * 16 + nb) * 64 + 16 * ct + fr) * 64 + ks * 32 + fq * 8);
}
__device__ __forceinline__ void rg_prompt_item(const Ctx& P, int l, int wi, LAS unsigned char* wl, int lane) {
    const int nb = wi & 15, c = wi < 4096 ? 1 + ((wi >> 4) & 31) : 0, b = wi < 4096 ? wi >> 9 : (wi - 4096) >> 4;
    const int L = c == 0 ? 16 : 64, t0 = c == 0 ? 0 : 16 + 64 * (c - 1), row0 = b * TP + t0, ch = nb * 64 + lane;
    const bf16_t* Z = (const bf16_t*)(P.ws + WS_Z); bf16_t* HG = (bf16_t*)(P.ws + WS_HG); bf16_t* A2 = (bf16_t*)(P.ws + WS_T); float* CAR = (float*)(P.ws + WS_CARRY);
    RgConst k; bf16x8 bw[2][4][2]; rg_load_const(P, l, ch, nb, lane, k, bw);
    float xm3 = 0.f, xm2 = 0.f, xm1 = 0.f;
    if (t0 > 0) { xm3 = bf2f(Z[(size_t)(row0 - 3) * NZ + ch]); xm2 = bf2f(Z[(size_t)(row0 - 2) * NZ + ch]); xm1 = bf2f(Z[(size_t)(row0 - 1) * NZ + ch]); }
    float h = 0.f, pacc = 1.f;
    unsigned xr[16], yr[16];
#pragma unroll
    for (int i = 0; i < 16; ++i) { xr[i] = Z[(size_t)(row0 + i) * NZ + ch]; yr[i] = Z[(size_t)(row0 + i) * NZ + ZC_RGY + ch]; }
    for (int sub = 0; sub < L / 16; ++sub) {
        const int r0 = row0 + sub * 16;
        float xc[16], a[16], bb[16], gl[16];
#pragma unroll
        for (int i = 0; i < 16; ++i) { const float xn = bf2f(xr[i]);
            xc[i] = k.cb + k.cw0 * xm3 + k.cw1 * xm2 + k.cw2 * xm1 + k.cw3 * xn; xm3 = xm2; xm2 = xm1; xm1 = xn; gl[i] = gelu_t(bf2f(yr[i])); }
        if (sub + 1 < L / 16) {
#pragma unroll
            for (int i = 0; i < 16; ++i) { xr[i] = Z[(size_t)(r0 + 16 + i) * NZ + ch]; yr[i] = Z[(size_t)(r0 + 16 + i) * NZ + ZC_RGY + ch]; } }
        rg_gates16(wl, xc, bw, k.ba, k.bx, k.sp8, lane, a, bb);
#pragma unroll
        for (int i = 0; i < 16; ++i) { h = a[i] * h + bb[i]; pacc *= a[i];
            HG[(size_t)(r0 + i) * D + ch] = f2bf(h * gl[i]); A2[(size_t)(r0 + i) * D + ch] = f2bf(pacc * gl[i]); }
    }
    { f32x2 ph = {pacc, h}; *(f32x2*)(CAR + (((size_t)b * NCH + c) * 1024 + ch) * 2) = ph; }
    if (c == NCH - 1) { float* rc = P.out + O_RCP + (((size_t)l * NB + b) * 3) * D + ch; rc[0] = xm3; rc[D] = xm2; rc[2 * D] = xm1; }
}
__device__ __forceinline__ void rg_fix_item(const Ctx& P, int l, int wi, int lane) {
    const int nb = wi & 15, c = (wi >> 4) % NCH, b = wi / (16 * NCH);
    const int L = c == 0 ? 16 : 64, t0 = c == 0 ? 0 : 16 + 64 * (c - 1), row0 = b * TP + t0, ch = nb * 64 + lane;
    bf16_t* HG = (bf16_t*)(P.ws + WS_HG); const bf16_t* A2 = (const bf16_t*)(P.ws + WS_T); const float* CAR = (const float*)(P.ws + WS_CARRY);
    float h = 0.f;
    for (int cc = 0; cc < c; ++cc) { const f32x2 ph = *(const f32x2*)(CAR + (((size_t)b * NCH + cc) * 1024 + ch) * 2); h = ph.x * h + ph.y; }
    if (c > 0) {
#pragma unroll
        for (int hf = 0; hf < 2; ++hf) { unsigned a1[32], a2[32];
#pragma unroll
            for (int i = 0; i < 32; ++i) { a1[i] = HG[(size_t)(row0 + hf * 32 + i) * D + ch]; a2[i] = A2[(size_t)(row0 + hf * 32 + i) * D + ch]; }
#pragma unroll
            for (int i = 0; i < 32; ++i) HG[(size_t)(row0 + hf * 32 + i) * D + ch] = f2bf(bf2f(a1[i]) + bf2f(a2[i]) * h); } }
    if (c == NCH - 1) { const f32x2 ph = *(const f32x2*)(CAR + (((size_t)b * NCH + c) * 1024 + ch) * 2); P.out[O_RHP + ((size_t)l * NB + b) * D + ch] = ph.x * h + ph.y; }
}
__device__ __forceinline__ void rg_sample_item(const Ctx& P, int l, int wi, LAS unsigned char* wl, int lane) {
    const int nb = wi & 15, sg = wi >> 4, ch = nb * 64 + lane;
    const bf16_t* Z = (const bf16_t*)(P.ws + WS_Z); bf16_t* HG = (bf16_t*)(P.ws + WS_HG);
    RgConst k; bf16x8 bw[2][4][2]; rg_load_const(P, l, ch, nb, lane, k, bw);
    const float* p_st = INP(P, 2); const float* p_h0 = INP(P, 3);
    float xc[16], a[16], bb[16];
#pragma unroll
    for (int i = 0; i < 16; ++i) { const int s = sg * 16 + i; const float* st = p_st + (((size_t)l * NS + s) * 3) * D + ch;
        const float s0 = st[0], s1 = st[D], s2 = st[2 * D], xn = bf2f(Z[(size_t)(MP + s) * NZ + ch]);
        xc[i] = k.cb + k.cw0 * s0 + k.cw1 * s1 + k.cw2 * s2 + k.cw3 * xn;
        float* rc = P.out + O_RCS + (((size_t)l * NS + s) * 3) * D + ch; rc[0] = s1; rc[D] = s2; rc[2 * D] = xn; }
    rg_gates16(wl, xc, bw, k.ba, k.bx, k.sp8, lane, a, bb);
#pragma unroll
    for (int i = 0; i < 16; ++i) { const int s = sg * 16 + i; const float h0 = p_h0[((size_t)l * NS + s) * D + ch];
        const float h = a[i] * h0 + bb[i];
        P.out[O_RHS + ((size_t)l * NS + s) * D + ch] = h;
        const float y = bf2f(Z[(size_t)(MP + s) * NZ + ZC_RGY + ch]); HG[(size_t)(MP + s) * D + ch] = f2bf(h * gelu_t(y)); }
}

__device__ __forceinline__ void gla_qk_item(const Ctx& P, int l, int wi, LAS unsigned char* wl, int lane) {
    const int half = wi & 1, h = (wi >> 1) & 3, c = (wi >> 3) % NCH, b = wi / (8 * NCH);
    const int L = c == 0 ? 16 : 64, t0 = c == 0 ? 0 : 16 + 64 * (c - 1), row0 = b * TP + t0, d = half * 64 + lane, col = h * 128 + d;
    const bf16_t* Z = (const bf16_t*)(P.ws + WS_Z);
    LAS float* BC = (LAS float*)wl;
    float wg[16]; const float* p_wg = INP(P, 16);
#pragma unroll
    for (int r = 0; r < 16; ++r) wg[r] = p_wg[((size_t)l * 16 + r) * 512 + col];
    const float bg = INP(P, 17)[l * 512 + col];
    float gv[16];
    { u32x4 g0 = {0u, 0u, 0u, 0u}, g1 = {0u, 0u, 0u, 0u};
      if (lane < L) { g0 = *(const u32x4*)(Z + (size_t)(row0 + lane) * NZ + ZC_GLR); g1 = *(const u32x4*)(Z + (size_t)(row0 + lane) * NZ + ZC_GLR + 8); }
      gv[0] = bflo(g0.x); gv[1] = bfhi(g0.x); gv[2] = bflo(g0.y); gv[3] = bfhi(g0.y); gv[4] = bflo(g0.z); gv[5] = bfhi(g0.z); gv[6] = bflo(g0.w); gv[7] = bfhi(g0.w);
      gv[8] = bflo(g1.x); gv[9] = bfhi(g1.x); gv[10] = bflo(g1.y); gv[11] = bfhi(g1.y); gv[12] = bflo(g1.z); gv[13] = bfhi(g1.z); gv[14] = bflo(g1.w); gv[15] = bfhi(g1.w); }
    float run = 0.f;
#pragma unroll 1
    for (int t = 0; t < 64; ++t) {
        if (t < L) { float zg = bg;
#pragma unroll
            for (int r = 0; r < 16; ++r) zg += __int_as_float(__builtin_amdgcn_readlane(__float_as_int(gv[r]), t)) * wg[r];
            run += -softplus_(-zg) * (1.f / 16.f); }
        BC[t * 64 + lane] = run;
    }
    const float bl = run, ebl = __expf(bl);
    const size_t idx = ((size_t)b * NCH + c) * 4 + h;
    bf16_t* QD = (bf16_t*)(P.ws + WS_QD) + idx * 8192; bf16_t* KD = (bf16_t*)(P.ws + WS_KD) + idx * 8192; bf16_t* KET = (bf16_t*)(P.ws + WS_KET) + idx * 8192;
    ((float*)(P.ws + WS_DEC))[((size_t)b * NCH + c) * 512 + col] = ebl;
#pragma unroll 1
    for (int hf = 0; hf < 2; ++hf) { unsigned qr[32], kr[32];
#pragma unroll
        for (int i = 0; i < 32; ++i) { const int t = hf * 32 + i; qr[i] = 0u; kr[i] = 0u;
            if (t < L) { qr[i] = Z[(size_t)(row0 + t) * NZ + ZC_Q + col]; kr[i] = Z[(size_t)(row0 + t) * NZ + ZC_K + col]; } }
#pragma unroll
        for (int t8 = 0; t8 < 4; ++t8) { float ke[8];
#pragma unroll
            for (int i = 0; i < 8; ++i) { const int t = hf * 32 + t8 * 8 + i; const float q = bf2f(qr[t8 * 8 + i]), kk = bf2f(kr[t8 * 8 + i]);
                const float eb = __expf(BC[t * 64 + lane]), ieb = __builtin_amdgcn_rcpf(eb);
                const int po = t * 128 + ((((d >> 3) ^ (t & 15)) << 3) | (d & 7));
                QD[po] = f2bf(q * 0.08838834764831845f * eb); const float kdv = kk * ieb; KD[po] = f2bf(kdv); ke[i] = kdv * ebl; }
            u32x4 o; o.x = pk2(ke[0], ke[1]); o.y = pk2(ke[2], ke[3]); o.z = pk2(ke[4], ke[5]); o.w = pk2(ke[6], ke[7]);
            const int tg = hf * 4 + t8;
            *(u32x4*)(KET + d * 64 + ((tg ^ (d & 7)) << 3)) = o; } }
}
__device__ __forceinline__ void gla_vt_item(const Ctx& P, int wi, int lane) {
    const int eg = wi & 3, h = (wi >> 2) & 3, c = (wi >> 4) % NCH, b = wi / (16 * NCH);
    const int L = c == 0 ? 16 : 64, t0 = c == 0 ? 0 : 16 + 64 * (c - 1), row0 = b * TP + t0, e = eg * 64 + lane;
    const bf16_t* Z = (const bf16_t*)(P.ws + WS_Z);
    bf16_t* VT = (bf16_t*)(P.ws + WS_VT) + (((size_t)b * NCH + c) * 4 + h) * 16384;
    unsigned v[64];
#pragma unroll
    for (int t = 0; t < 64; ++t) v[t] = t < L ? (unsigned)Z[(size_t)(row0 + t) * NZ + ZC_V + h * 256 + e] : 0u;
#pragma unroll
    for (int t8 = 0; t8 < 8; ++t8) { u32x4 o; o.x = v[t8 * 8 + 0] | (v[t8 * 8 + 1] << 16); o.y = v[t8 * 8 + 2] | (v[t8 * 8 + 3] << 16); o.z = v[t8 * 8 + 4] | (v[t8 * 8 + 5] << 16); o.w = v[t8 * 8 + 6] | (v[t8 * 8 + 7] << 16);
        *(u32x4*)(VT + e * 64 + t8 * 8) = o; }
}

__device__ __forceinline__ void gla_prompt_unit(const Ctx& P, int l, int b, int h, int eh, LAS unsigned char* lds) {
    const int tid = opaque_tid(), lane = tid & 63, w = __builtin_amdgcn_readfirstlane(tid >> 6), fr = lane & 15, fq = lane >> 4;
    constexpr int QS = 256, ES = 128, KS = 144, BUFB = 3 * 16384, A_OFF = 3 * BUFB, DEC_OFF = A_OFF + 64 * KS;
    const bf16_t* Z = (const bf16_t*)(P.ws + WS_Z); bf16_t* OG = (bf16_t*)(P.ws + WS_OG);
    const bf16_t* QDg = (const bf16_t*)(P.ws + WS_QD); const bf16_t* KDg = (const bf16_t*)(P.ws + WS_KD); const bf16_t* KETg = (const bf16_t*)(P.ws + WS_KET); const bf16_t* VTg = (const bf16_t*)(P.ws + WS_VT);
    const float* DEC = (const float*)(P.ws + WS_DEC); float* GSS = (float*)(P.ws + WS_GSS);
    const int e0w = eh * 128 + 16 * w;
    LAS unsigned char* Abuf = lds + A_OFF; LAS float* DECL = (LAS float*)(lds + DEC_OFF);
    f32x4 S[8];
#pragma unroll
    for (int dt = 0; dt < 8; ++dt) S[dt] = (f32x4){0.f, 0.f, 0.f, 0.f};
    bf16x8 vt[2], vtA[2], vtB[2];
    const int grp = w >> 2;
#define GLA_VT(dst, cc) do { const size_t _ix = ((size_t)b * NCH + (cc)) * 4 + h; \
        _Pragma("unroll") for (int _ks = 0; _ks < 2; ++_ks) dst[_ks] = *(const bf16x8*)(VTg + _ix * 16384 + (size_t)(e0w + fr) * 64 + _ks * 32 + fq * 8); } while (0)
#define GLA_DMA(cc, bufi, p0, pstep, np) do { const size_t _ix = ((size_t)b * NCH + (cc)) * 4 + h; LAS unsigned char* _bb = lds + (bufi) * BUFB; \
        _Pragma("unroll") for (int _i = 0; _i < (np); ++_i) { const int _pc = (p0) + (pstep) * _i; \
            __builtin_amdgcn_global_load_lds((const unsigned*)((const char*)(QDg + _ix * 8192) + _pc * 1024 + lane * 16), (LAS unsigned*)(_bb + _pc * 1024), 16, 0, 0); \
            __builtin_amdgcn_global_load_lds((const unsigned*)((const char*)(KDg + _ix * 8192) + _pc * 1024 + lane * 16), (LAS unsigned*)(_bb + 16384 + _pc * 1024), 16, 0, 0); \
            __builtin_amdgcn_global_load_lds((const unsigned*)((const char*)(KETg + _ix * 8192) + _pc * 1024 + lane * 16), (LAS unsigned*)(_bb + 32768 + _pc * 1024), 16, 0, 0); } } while (0)
    GLA_VT(vtA, 0); GLA_VT(vtB, 1);
    float d1 = 0.f;
    if (tid < 128) { DECL[tid] = DEC[((size_t)b * NCH) * 512 + h * 128 + tid]; d1 = DEC[((size_t)b * NCH + 1) * 512 + h * 128 + tid]; }
    GLA_DMA(0, 0, w, 8, 2); GLA_DMA(1, 1, w, 8, 2);
    asm volatile("s_waitcnt vmcnt(0)" ::: "memory");
    __syncthreads();
    int bufc = 0;
    for (int c = 0; c < NCH; ++c) {
        const int bufn = bufc == 2 ? 0 : bufc + 1, bufnn = bufn == 2 ? 0 : bufn + 1;
        LAS unsigned char* qb = lds + bufc * BUFB; LAS unsigned char* kb = qb + 16384; LAS unsigned char* eb = qb + 32768;
        vt[0] = vtA[0]; vt[1] = vtA[1]; vtA[0] = vtB[0]; vtA[1] = vtB[1];
        float dnew = 0.f;
        if (c + 2 < NCH) { GLA_VT(vtB, c + 2);
            if (tid < 128) dnew = DEC[((size_t)b * NCH + c + 2) * 512 + h * 128 + tid];
            if (grp == (c & 1)) GLA_DMA(c + 2, bufnn, (w & 3), 4, 4); }
        const int L = c == 0 ? 16 : 64, row0 = b * TP + (c == 0 ? 0 : 16 + 64 * (c - 1));
        { bf16x8 ka[2][4], qv[2][4];
#pragma unroll
          for (int ii = 0; ii < 2; ++ii) { const int idx = 2 * w + ii, si = idx >> 2, ti = idx & 3;
#pragma unroll
              for (int ks = 0; ks < 4; ++ks) { const int sw = ((ks * 4 + fq) ^ fr) * 16; ka[ii][ks] = *(const LAS bf16x8*)(kb + (16 * si + fr) * QS + sw); qv[ii][ks] = *(const LAS bf16x8*)(qb + (16 * ti + fr) * QS + sw); } }
          __builtin_amdgcn_sched_barrier(0);
          f32x4 acc[2];
#pragma unroll
          for (int ii = 0; ii < 2; ++ii) acc[ii] = (f32x4){0.f, 0.f, 0.f, 0.f};
#pragma unroll
          for (int ks = 0; ks < 4; ++ks)
#pragma unroll
              for (int ii = 0; ii < 2; ++ii) acc[ii] = MFMA16(ka[ii][ks], qv[ii][ks], acc[ii]);
#pragma unroll
          for (int ii = 0; ii < 2; ++ii) { const int idx = 2 * w + ii, si = idx >> 2, ti = idx & 3;
              const int t = 16 * ti + fr;
              float a0 = acc[ii][0], a1 = acc[ii][1], a2 = acc[ii][2], a3 = acc[ii][3]; const int s0 = 16 * si + fq * 4;
              if (s0 + 0 > t) a0 = 0.f; if (s0 + 1 > t) a1 = 0.f; if (s0 + 2 > t) a2 = 0.f; if (s0 + 3 > t) a3 = 0.f;
              u32x2 ow; ow.x = pk2(a0, a1); ow.y = pk2(a2, a3);
              *(LAS u32x2*)(Abuf + t * KS + s0 * 2) = ow; } }
        __syncthreads();
        f32x4 o[4];
        { bf16x8 af[2][4]; u32x2 q0[4][4], q1[4][4];
#pragma unroll
          for (int ks = 0; ks < 2; ++ks)
#pragma unroll
              for (int tt = 0; tt < 4; ++tt) af[ks][tt] = *(const LAS bf16x8*)(Abuf + (16 * tt + fr) * KS + ks * 64 + fq * 16);
#pragma unroll
          for (int ks = 0; ks < 4; ++ks)
#pragma unroll
              for (int tt = 0; tt < 4; ++tt) { q0[ks][tt] = *(const LAS u32x2*)(qb + (16 * tt + fr) * QS + (((4 * ks + (fq >> 1)) ^ fr) * 16) + 8 * (fq & 1)); q1[ks][tt] = *(const LAS u32x2*)(qb + (16 * tt + fr) * QS + (((4 * ks + 2 + (fq >> 1)) ^ fr) * 16) + 8 * (fq & 1)); }
          bf16x8 sa[4];
#pragma unroll
          for (int ks = 0; ks < 4; ++ks) { u32x4 pw; pw.x = pk2(S[2 * ks][0], S[2 * ks][1]); pw.y = pk2(S[2 * ks][2], S[2 * ks][3]); pw.z = pk2(S[2 * ks + 1][0], S[2 * ks + 1][1]); pw.w = pk2(S[2 * ks + 1][2], S[2 * ks + 1][3]); sa[ks] = __builtin_bit_cast(bf16x8, pw); }
          __builtin_amdgcn_sched_barrier(0);
#pragma unroll
          for (int tt = 0; tt < 4; ++tt) o[tt] = (f32x4){0.f, 0.f, 0.f, 0.f};
#pragma unroll
          for (int ks = 0; ks < 2; ++ks)
#pragma unroll
              for (int tt = 0; tt < 4; ++tt) o[tt] = MFMA16(vt[ks], af[ks][tt], o[tt]);
#pragma unroll
          for (int ks = 0; ks < 4; ++ks)
#pragma unroll
              for (int tt = 0; tt < 4; ++tt) { u32x4 qw; qw.x = q0[ks][tt].x; qw.y = q0[ks][tt].y; qw.z = q1[ks][tt].x; qw.w = q1[ks][tt].y;
                  o[tt] = MFMA16(sa[ks], __builtin_bit_cast(bf16x8, qw), o[tt]); } }
        __builtin_amdgcn_sched_barrier(0);
        { const LAS float* dp = DECL + bufc * 128; bf16x8 kf[8][2]; f32x4 dv[8];
#pragma unroll
          for (int dt = 0; dt < 8; ++dt) { dv[dt] = *(const LAS f32x4*)(dp + 16 * dt + fq * 4);
#pragma unroll
              for (int ks = 0; ks < 2; ++ks) kf[dt][ks] = *(const LAS bf16x8*)(eb + (16 * dt + fr) * ES + (((ks * 4 + fq) ^ (fr & 7)) * 16)); }
          __builtin_amdgcn_sched_barrier(0);
#pragma unroll
          for (int dt = 0; dt < 8; ++dt) S[dt] = S[dt] * dv[dt];
#pragma unroll
          for (int ks = 0; ks < 2; ++ks)
#pragma unroll
              for (int dt = 0; dt < 8; ++dt) S[dt] = MFMA16(kf[dt][ks], vt[ks], S[dt]); }
        __builtin_amdgcn_sched_barrier(0);
        if (grp == ((c + 1) & 1)) asm volatile("s_waitcnt vmcnt(0)" ::: "memory");
        if (c + 1 < NCH && tid < 128) DECL[bufn * 128 + tid] = d1;
        d1 = dnew;
#pragma unroll
        for (int tt = 0; tt < 4; ++tt) { const int t = 16 * tt + fr;
            u32x4 sqw; sqw.x = pk2(o[tt][0] * o[tt][0], o[tt][1] * o[tt][1]); sqw.y = pk2(o[tt][2] * o[tt][2], o[tt][3] * o[tt][3]); sqw.z = 0u; sqw.w = 0u;
            const u32x4 onesw = {0x3F803F80u, 0x3F803F80u, 0x3F803F80u, 0x3F803F80u};
            const f32x4 red = MFMA16(__builtin_bit_cast(bf16x8, onesw), __builtin_bit_cast(bf16x8, sqw), ((f32x4){0.f, 0.f, 0.f, 0.f}));
            const float p = red[0];
            if (t < L) { const size_t row = (size_t)(row0 + t);
                u32x2 ow; ow.x = pk2(o[tt][0], o[tt][1]); ow.y = pk2(o[tt][2], o[tt][3]);
                *(u32x2*)(OG + row * D + h * 256 + e0w + fq * 4) = ow;
                if (fq == 0) GSS[(row * 4 + h) * 16 + eh * 8 + w] = p; } }
        LDS_BARRIER();
        bufc = bufn;
    }
    { float* gp = P.out + O_GP + (((size_t)l * NB + b) * 4 + h) * 128 * 256;
#pragma unroll
      for (int dt = 0; dt < 8; ++dt)
#pragma unroll
          for (int j = 0; j < 4; ++j) gp[(size_t)(16 * dt + fq * 4 + j) * 256 + e0w + fr] = S[dt][j]; }
#undef GLA_VT
#undef GLA_DMA
}

__device__ __forceinline__ void unpack8(const u32x4 w, float (&f)[8]) { f[0] = bflo(w.x); f[1] = bfhi(w.x); f[2] = bflo(w.y); f[3] = bfhi(w.y); f[4] = bflo(w.z); f[5] = bfhi(w.z); f[6] = bflo(w.w); f[7] = bfhi(w.w); }
__device__ __forceinline__ void load8f(const float* p, float (&f)[8]) { const f32x4 a = *(const f32x4*)p, b = *(const f32x4*)(p + 4); f[0] = a[0]; f[1] = a[1]; f[2] = a[2]; f[3] = a[3]; f[4] = b[0]; f[5] = b[1]; f[6] = b[2]; f[7] = b[3]; }
__device__ __forceinline__ void store8f(float* p, const float (&f)[8]) { *(f32x4*)p = (f32x4){f[0], f[1], f[2], f[3]}; *(f32x4*)(p + 4) = (f32x4){f[4], f[5], f[6], f[7]}; }
__device__ __forceinline__ void gla_finalize(const Ctx& P, int l) {
    const bf16_t* Z = (const bf16_t*)(P.ws + WS_Z); bf16_t* OG = (bf16_t*)(P.ws + WS_OG); const float* GSS = (const float*)(P.ws + WS_GSS);
    const float* p_gn = INP(P, 18) + (size_t)l * 1024;
    const int gt = opaque_bid() * 512 + opaque_tid(), NT = gridDim.x * 512;
    for (int it0 = gt; it0 < MP * 128; it0 += 4 * NT) {
        u32x4 ovw[4], gvw[4]; float rs[4];
#pragma unroll
        for (int u = 0; u < 4; ++u) { const int it = it0 + u * NT; if (it < MP * 128) { const int row = it >> 7, c8 = (it & 127) * 8, h = c8 >> 8;
            ovw[u] = *(const u32x4*)(OG + (size_t)row * D + c8); gvw[u] = *(const u32x4*)(Z + (size_t)row * NZ + ZC_GOUT + c8);
            rs[u] = rsqrtf(ss_total(GSS + (size_t)h * 16, row * 4) * (1.f / 256.f) + EPS); } }
#pragma unroll
        for (int u = 0; u < 4; ++u) { const int it = it0 + u * NT; if (it < MP * 128) { const int row = it >> 7, c8 = (it & 127) * 8;
            float ov[8], gv[8], gn[8]; unpack8(ovw[u], ov); unpack8(gvw[u], gv); load8f(p_gn + c8, gn);
#pragma unroll
            for (int i = 0; i < 8; ++i) ov[i] = ov[i] * rs[u] * gn[i] * silu_(gv[i]);
            u32x4 o; o.x = pk2(ov[0], ov[1]); o.y = pk2(ov[2], ov[3]); o.z = pk2(ov[4], ov[5]); o.w = pk2(ov[6], ov[7]);
            *(u32x4*)(OG + (size_t)row * D + c8) = o; } }
    }
}

__device__ __forceinline__ void gla_sample_item(const Ctx& P, int l, int s, int h, LAS unsigned char* lds) {
    const int tid = opaque_tid(), lane = tid & 63, w = __builtin_amdgcn_readfirstlane(tid >> 6);
    LAS float* AL = (LAS float*)lds; LAS float* KK = AL + 128; LAS float* QQ = KK + 128; LAS float* OP = QQ + 128; LAS float* RED = OP + 8 * 256;
    const bf16_t* Z = (const bf16_t*)(P.ws + WS_Z); bf16_t* OG = (bf16_t*)(P.ws + WS_OG);
    const size_t row = (size_t)(MP + s);
    const float* p_wg = INP(P, 16); const float* p_bg = INP(P, 17); const float* p_s0 = INP(P, 4); const float* p_gn = INP(P, 18);
    if (tid < 128) { const int col = h * 128 + tid; float zg = p_bg[l * 512 + col];
#pragma unroll
        for (int r = 0; r < 16; ++r) zg += bf2f(Z[row * NZ + ZC_GLR + r]) * p_wg[((size_t)l * 16 + r) * 512 + col];
        AL[tid] = __expf(-softplus_(-zg) * (1.f / 16.f)); KK[tid] = bf2f(Z[row * NZ + ZC_K + col]); QQ[tid] = bf2f(Z[row * NZ + ZC_Q + col]) * 0.08838834764831845f; }
    __syncthreads();
    { const int e0 = lane * 4; const u32x2 vw = *(const u32x2*)(Z + row * NZ + ZC_V + h * 256 + e0);
      const f32x4 v4 = {bflo(vw.x), bfhi(vw.x), bflo(vw.y), bfhi(vw.y)}; f32x4 o4 = {0.f, 0.f, 0.f, 0.f};
      const size_t sb = (((size_t)l * NS + s) * 4 + h) * 128 * 256;
      const float* S0 = p_s0 + sb; float* SO = P.out + O_GS + sb;
      f32x4 s0[16];
#pragma unroll
      for (int dd = 0; dd < 16; ++dd) s0[dd] = *(const f32x4*)(S0 + (size_t)(16 * w + dd) * 256 + e0);
#pragma unroll
      for (int dd = 0; dd < 16; ++dd) { const int d = 16 * w + dd;
          const f32x4 sn = s0[dd] * AL[d] + v4 * KK[d]; *(f32x4*)(SO + (size_t)d * 256 + e0) = sn; o4 = o4 + sn * QQ[d]; }
      *(LAS f32x4*)(OP + w * 256 + e0) = o4; }
    __syncthreads();
    float ov = 0.f;
    if (tid < 256) {
#pragma unroll
        for (int ww = 0; ww < 8; ++ww) ov += OP[ww * 256 + tid];
        float p = ov * ov;
#pragma unroll
        for (int o = 1; o < 64; o <<= 1) p += __shfl_xor(p, o);
        if (lane == 0) RED[w] = p; }
    __syncthreads();
    if (tid < 256) { const float tot = RED[0] + RED[1] + RED[2] + RED[3]; const float rs = rsqrtf(tot * (1.f / 256.f) + EPS);
        const float gn = p_gn[((size_t)l * 4 + h) * 256 + tid]; const float go = bf2f(Z[row * NZ + ZC_GOUT + h * 256 + tid]);
        OG[row * D + h * 256 + tid] = f2bf(ov * rs * gn * silu_(go)); }
    __syncthreads();
}

__device__ __forceinline__ void phase_geglu(const Ctx& P, int l) {
    const bf16_t* U = (const bf16_t*)(P.ws + WS_U); bf16_t* ACT = (bf16_t*)(P.ws + WS_ACT);
    const float* cw = INP(P, 24) + (size_t)l * 3 * DUP; const float* cbp = INP(P, 25) + (size_t)l * DUP; const float* p_fst = INP(P, 5);
    const int gt = opaque_bid() * 512 + opaque_tid(), NT = gridDim.x * 512;
    constexpr int NCG = DFF / 8, NRUN = MP / 8;
    for (int it = gt; it < NCG * (NRUN + NS); it += NT) {
        const int cg8 = it % NCG, run = it / NCG, f0 = cg8 * 8;
        float wg[3][8], wv[3][8], bg[8], bv[8];
#pragma unroll
        for (int j = 0; j < 3; ++j) { load8f(cw + (size_t)j * DUP + f0, wg[j]); load8f(cw + (size_t)j * DUP + DFF + f0, wv[j]); }
        load8f(cbp + f0, bg); load8f(cbp + DFF + f0, bv);
        float g2[8], g1[8], v2[8], v1[8];
        if (run < NRUN) {
            const int b = run / 258, t0 = (run % 258) * 8; const size_t row0 = (size_t)b * TP + t0;
            if (t0 == 0) {
#pragma unroll
                for (int i = 0; i < 8; ++i) { g2[i] = g1[i] = v2[i] = v1[i] = 0.f; }
            } else { unpack8(*(const u32x4*)(U + (row0 - 2) * DUP + f0), g2); unpack8(*(const u32x4*)(U + (row0 - 1) * DUP + f0), g1);
                     unpack8(*(const u32x4*)(U + (row0 - 2) * DUP + DFF + f0), v2); unpack8(*(const u32x4*)(U + (row0 - 1) * DUP + DFF + f0), v1); }
            u32x4 ug8[8], uv8[8];
#pragma unroll
            for (int r = 0; r < 8; ++r) { ug8[r] = *(const u32x4*)(U + (row0 + r) * DUP + f0); uv8[r] = *(const u32x4*)(U + (row0 + r) * DUP + DFF + f0); }
#pragma unroll
            for (int r = 0; r < 8; ++r) { float g0[8], v0[8], a[8];
                unpack8(ug8[r], g0); unpack8(uv8[r], v0);
#pragma unroll
                for (int i = 0; i < 8; ++i) { const float ug = bg[i] + wg[0][i] * g2[i] + wg[1][i] * g1[i] + wg[2][i] * g0[i], uv = bv[i] + wv[0][i] * v2[i] + wv[1][i] * v1[i] + wv[2][i] * v0[i];
                    a[i] = gelu_t(ug) * uv; g2[i] = g1[i]; g1[i] = g0[i]; v2[i] = v1[i]; v1[i] = v0[i]; }
                u32x4 o; o.x = pk2(a[0], a[1]); o.y = pk2(a[2], a[3]); o.z = pk2(a[4], a[5]); o.w = pk2(a[6], a[7]);
                *(u32x4*)(ACT + (row0 + r) * DFF + f0) = o; }
            if (t0 == TP - 8) { float* fo = P.out + O_FCP + (((size_t)l * NB + b) * 2) * DUP;
                store8f(fo + f0, g2); store8f(fo + DUP + f0, g1); store8f(fo + DFF + f0, v2); store8f(fo + DUP + DFF + f0, v1); }
        } else {
            const int s = run - NRUN; const size_t row = (size_t)MP + s;
            const float* st = p_fst + (((size_t)l * NS + s) * 2) * DUP;
            load8f(st + f0, g2); load8f(st + DUP + f0, g1); load8f(st + DFF + f0, v2); load8f(st + DUP + DFF + f0, v1);
            float g0[8], v0[8], a[8];
            unpack8(*(const u32x4*)(U + row * DUP + f0), g0); unpack8(*(const u32x4*)(U + row * DUP + DFF + f0), v0);
#pragma unroll
            for (int i = 0; i < 8; ++i) { const float ug = bg[i] + wg[0][i] * g2[i] + wg[1][i] * g1[i] + wg[2][i] * g0[i], uv = bv[i] + wv[0][i] * v2[i] + wv[1][i] * v1[i] + wv[2][i] * v0[i];
                a[i] = gelu_t(ug) * uv; }
            u32x4 o; o.x = pk2(a[0], a[1]); o.y = pk2(a[2], a[3]); o.z = pk2(a[4], a[5]); o.w = pk2(a[6], a[7]);
            *(u32x4*)(ACT + row * DFF + f0) = o;
            float* fo = P.out + O_FCS + (((size_t)l * NS + s) * 2) * DUP;
            store8f(fo + f0, g1); store8f(fo + DUP + f0, g0); store8f(fo + DFF + f0, v1); store8f(fo + DUP + DFF + f0, v0);
        }
    }
}

#define XB_TMO      128
#define XB_XCNT(j)  (256  + 64 * (j))
#define XB_XSUB(j)  (1280 + 64 * (j))
#define XB_XGEN(j)  (2304 + 64 * (j))
#define XB_TOP      3328
#define XB_TOPGEN   3392
#define XCD_BAR_WORDS 3456
#define XB_SPIN_CAP (1u << 18)

__device__ __forceinline__ unsigned xb_ld(unsigned* p)              { return __hip_atomic_load(p, __ATOMIC_RELAXED, __HIP_MEMORY_SCOPE_AGENT); }
__device__ __forceinline__ unsigned xb_add(unsigned* p, unsigned v) { return __hip_atomic_fetch_add(p, v, __ATOMIC_RELAXED, __HIP_MEMORY_SCOPE_AGENT); }
__device__ __forceinline__ unsigned xb_xcc_id() { return (unsigned)__builtin_amdgcn_s_getreg((3 << 11) | 20) & 0xFu; }
#define XB_SPIN(cond, bar) do { unsigned _sp = 0; while (cond) { __builtin_amdgcn_s_sleep(1); \
    if ((++_sp & 255u) == 0u) { if (xb_ld(&(bar)[XB_TMO])) break; if (_sp > XB_SPIN_CAP) { atomicAdd(&(bar)[XB_TMO], 1u); break; } } } } while (0)

struct XcdBarrier {
    unsigned* bar; unsigned x;
    volatile LAS unsigned* st;
};

__device__ __forceinline__ XcdBarrier xcd_barrier_post(unsigned* bar, volatile LAS unsigned* st) {
    XcdBarrier b; b.bar = bar; b.x = xb_xcc_id(); b.st = st;
    if (threadIdx.x == 0) (void)xb_add(&bar[XB_XCNT(b.x)], 1u);
    return b;
}
__device__ __forceinline__ void xcd_barrier_complete(unsigned* bar, unsigned x, unsigned& nloc, unsigned& nx) {
    const unsigned G = gridDim.x * gridDim.y * gridDim.z;
    unsigned sum, cnt, mine, sp = 0u;
    for (;;) {
        sum = 0u; cnt = 0u; mine = 0u;
#pragma unroll
        for (unsigned j = 0; j < 16; ++j) { const unsigned c = xb_ld(&bar[XB_XCNT(j)]); sum += c; cnt += (c > 0u) ? 1u : 0u; mine = (j == x) ? c : mine; }
        if (sum == G) break;
        __builtin_amdgcn_s_sleep(1);
        if ((++sp & 255u) == 0u) { if (xb_ld(&bar[XB_TMO])) break; if (sp > XB_SPIN_CAP) { atomicAdd(&bar[XB_TMO], 1u); break; } }
    }
    nloc = mine > 0u ? mine : 1u; nx = cnt > 0u ? cnt : 1u;
}

__device__ __forceinline__ void xcd_barrier(const XcdBarrier& b) {
    asm volatile("s_waitcnt vmcnt(0)" ::: "memory");
    __syncthreads();
    if (threadIdx.x == 0) {
        unsigned* bar = b.bar;
        __builtin_amdgcn_s_waitcnt(0);
        unsigned nloc = b.st[0], nx = b.st[1];
        if (nloc == 0u) { xcd_barrier_complete(bar, b.x, nloc, nx); b.st[0] = nloc; b.st[1] = nx; }
        const unsigned old = xb_add(&bar[XB_XSUB(b.x)], 1u);
        const unsigned gen = old / nloc;
        if (old + 1u == (gen + 1u) * nloc) {
            __builtin_amdgcn_fence(__ATOMIC_RELEASE, "agent");
            asm volatile("s_waitcnt vmcnt(0)" ::: "memory");
            const unsigned og = xb_add(&bar[XB_TOP], 1u);
            const unsigned tg = og / nx;
            if (og + 1u == (tg + 1u) * nx) xb_add(&bar[XB_TOPGEN], 1u);
            else XB_SPIN(xb_ld(&bar[XB_TOPGEN]) == tg, bar);
            __builtin_amdgcn_fence(__ATOMIC_ACQUIRE, "agent");
            xb_add(&bar[XB_XGEN(b.x)], 1u);
            asm volatile("s_waitcnt vmcnt(0)" ::: "memory");
        } else {
            XB_SPIN(xb_ld(&bar[XB_XGEN(b.x)]) == gen, bar);
            __builtin_amdgcn_fence(__ATOMIC_ACQUIRE, "agent");
            asm volatile("s_waitcnt vmcnt(0)" ::: "memory");
        }
    }
    __syncthreads();
}


__global__ void __launch_bounds__(512, 2) mega(Params KP) {
    extern __shared__ __attribute__((aligned(16))) unsigned char lds_raw[];
    LAS unsigned char* lds = (LAS unsigned char*)lds_raw;
    cg::grid_group grid = cg::this_grid();
    const int G = gridDim.x;
    const int lo = KP.ph_lo, hi = KP.ph_hi;
    if (threadIdx.x == 0) { LAS unsigned long long* tab = (LAS unsigned long long*)(lds + PTAB_OFF);
#pragma unroll
        for (int i = 0; i < 28; ++i) tab[i] = (unsigned long long)KP.in[i]; }
    __syncthreads();
    volatile LAS unsigned* bst = (volatile LAS unsigned*)(lds + PTAB_OFF + 240);
    if (threadIdx.x < 2) bst[threadIdx.x] = 0u;
    __syncthreads();
    Ctx P; P.pt = (LAS const unsigned long long*)(lds + PTAB_OFF); P.out = KP.out; P.ws = KP.ws;
    const XcdBarrier xbar = xcd_barrier_post((unsigned*)(KP.ws + WS_BAR), bst);
    int ph = 0;
#ifndef PHASE_MASK
#define PHASE_MASK 0x3ff
#endif
#define PM(k) ((PHASE_MASK >> (k)) & 1)
#ifndef P3SEL
#define P3SEL 0xf
#endif
#define P3S(k) ((P3SEL >> (k)) & 1)
#ifndef REP1
#define REP1 1
#endif
#ifndef REP2
#define REP2 1
#endif
#ifndef REP3
#define REP3 1
#endif
#ifndef REP6
#define REP6 1
#endif
#ifndef REP7
#define REP7 1
#endif
#define RUN() (ph >= lo && ph < hi)
#define GSYNC() xcd_barrier(xbar)
#define SEAM() do { if (ph >= lo && ph + 1 < hi) GSYNC(); ++ph; } while (0)
#define PHASE_LOCALS() unsigned char* ws = opaque_ptr(P.ws); const int bid = opaque_bid(); (void)ws; (void)bid
#define WAVE_LOCALS() const int tid = opaque_tid(), lane = tid & 63, w = __builtin_amdgcn_readfirstlane(tid >> 6); (void)lane; (void)w

    if (PM(0) && RUN()) phase0(P, lds);
    if (ph >= lo && ph + 1 < hi) grid.sync();
    ++ph;
    for (int l = 0; l < DEPTH; ++l) {
        if (PM(1) && RUN()) for (int rep = 0; rep < REP1; ++rep) { if (rep) GSYNC(); PHASE_LOCALS(); pg8::Gemm g{(const bf16_t*)(ws + WS_XB), (const bf16_t*)(ws + WS_WIN) + (size_t)l * NZ * D, MM, 7168, D}; pg8::StaticOrder S; S.init(MM, 7168, G, bid);
            EpiScale E{(bf16_t*)(ws + WS_Z), NZ, (const float*)(ws + WS_SS)};
            int np = 2; asm volatile("" : "+s"(np));
            for (int pass = 0; pass < np; ++pass) {
                if ((pass == 0) == ((bid & 1) != 0)) {
                    tail_splitk<4, 4>(lds, g.A, g.Bt, D, MM, 4, 0, 112, 0, E);
                    tail_splitk<8, 1>(lds, g.A, g.Bt, D, 0, M / 128, ZC_GLR, 1, 192, E); }
                else pg8::gemm_phase<EpiScale>(lds, g, S, E); } }
        SEAM();
        if (PM(2) && RUN()) for (int rep = 0; rep < REP2; ++rep) { if (rep) GSYNC(); PHASE_LOCALS(); WAVE_LOCALS();
            LAS unsigned char* wl = lds + w * 16384;
            const int nitems = 4224 + 2112 + 4224, first = bid * 8 + w, stride = G * 8, cnt = first < nitems ? (nitems - 1 - first) / stride + 1 : 0;
            for (int k = 0; k < cnt; ++k) { const int it = first + ((w & 1) ? cnt - 1 - k : k) * stride;
                if (it < 4224) rg_prompt_item(P, l, it, wl, lane);
                else if (it < 6336) gla_qk_item(P, l, it - 4224, wl, lane);
                else gla_vt_item(P, it - 6336, lane);
            }
        }
        SEAM();
        if (PM(3) && RUN()) for (int rep = 0; rep < REP3; ++rep) { if (rep) GSYNC(); PHASE_LOCALS(); WAVE_LOCALS();
            LAS unsigned char* wl = lds + w * 16384;
            if (bid < 64) { const int bh = (bid & 7) | ((bid >> 4) << 3);
                if (P3S(0)) gla_prompt_unit(P, l, bh >> 2, bh & 3, (bid >> 3) & 1, lds); }
            else {
                for (int it = bid - 64; it < 528 + 16 + 512; it += G - 64) {
                    if (it < 528) { if (P3S(1)) rg_fix_item(P, l, it * 8 + w, lane); }
                    else if (it < 544) { if (P3S(2)) rg_sample_item(P, l, (it - 528) * 8 + w, wl, lane); }
                    else { if (P3S(3)) { __syncthreads(); gla_sample_item(P, l, (it - 544) >> 2, (it - 544) & 3, lds); } }
                }
                if (l + 1 < DEPTH) { __syncthreads(); prep_weights(P, lds, l + 1, (bid - 64) * 8 + w, (G - 64) * 8); }
            }
        }
        SEAM();
        if (PM(4) && RUN()) {
            gla_finalize(P, l);
            { PHASE_LOCALS(); pg8::StaticOrder S; S.init(MM, D, G, bid);
              pg8::Gemm g{(const bf16_t*)(ws + WS_HG), (const bf16_t*)(ws + WS_WA) + (size_t)l * D * D, MM, D, D}; EpiYa E{(bf16_t*)(ws + WS_T), (const bf16_t*)(ws + WS_Z)}; { int np = 2; asm volatile("" : "+s"(np)); for (int pass = 0; pass < np; ++pass) { if ((pass == 0) == ((bid & 1) != 0)) tail_splitk<2, 4>(lds, g.A, g.Bt, D, MM, 8, 0, 16, 0, E); else pg8::gemm_phase<EpiYa>(lds, g, S, E); } } }
            GSYNC();
            { PHASE_LOCALS(); pg8::StaticOrder S; S.init(MM, D, G, bid);
              pg8::Gemm g{(const bf16_t*)(ws + WS_OG), (const bf16_t*)(ws + WS_WB) + (size_t)l * D * D, MM, D, D}; EpiMerge E{(const bf16_t*)(ws + WS_T), (const bf16_t*)(ws + WS_Z), (bf16_t*)(ws + WS_MG)}; { int np = 2; asm volatile("" : "+s"(np)); for (int pass = 0; pass < np; ++pass) { if ((pass == 0) == ((bid & 1) != 0)) tail_splitk<2, 4>(lds, g.A, g.Bt, D, MM, 8, 0, 16, 0, E); else pg8::gemm_phase<EpiMerge>(lds, g, S, E); } } } }
        SEAM();
        if (PM(5) && RUN()) { PHASE_LOCALS(); pg8::Gemm g{(const bf16_t*)(ws + WS_MG), (const bf16_t*)(ws + WS_WO) + (size_t)l * D * D, MM, D, D}; pg8::StaticOrder S; S.init(MM, D, G, bid);
            EpiResid E{(bf16_t*)(ws + WS_XB), (float*)(ws + WS_SS) + (size_t)M * 16}; { int np = 2; asm volatile("" : "+s"(np)); for (int pass = 0; pass < np; ++pass) { if ((pass == 0) == ((bid & 1) != 0)) tail_splitk<2, 4>(lds, g.A, g.Bt, D, MM, 8, 0, 16, 0, E); else pg8::gemm_phase<EpiResid>(lds, g, S, E); } } }
        SEAM();
        if (PM(6) && RUN()) for (int rep = 0; rep < REP6; ++rep) { if (rep) GSYNC(); PHASE_LOCALS(); pg8::Gemm g{(const bf16_t*)(ws + WS_XB), (const bf16_t*)(ws + WS_WUP) + (size_t)l * DUP * D, MM, DUP, D}; pg8::StaticOrder S; S.init(MM, DUP, G, bid);
            EpiScale E{(bf16_t*)(ws + WS_U), DUP, (const float*)(ws + WS_SS) + (size_t)M * 16};
            int np = 2; asm volatile("" : "+s"(np));
            for (int pass = 0; pass < np; ++pass) {
                if ((pass == 0) == ((bid & 1) != 0)) tail_splitk<4, 4>(lds, g.A, g.Bt, D, MM, 4, 0, 96, 0, E);
                else pg8::gemm_phase<EpiScale>(lds, g, S, E); } }
        SEAM();
        if (PM(7) && RUN()) for (int rep = 0; rep < REP7; ++rep) { if (rep) GSYNC(); phase_geglu(P, l); }
        SEAM();
        if (PM(8) && RUN()) { PHASE_LOCALS(); pg8::Gemm g{(const bf16_t*)(ws + WS_ACT), (const bf16_t*)(ws + WS_WDN) + (size_t)l * D * DFF, MM, D, DFF}; pg8::StaticOrder S; S.init(MM, D, G, bid);
            EpiResid E{(bf16_t*)(ws + WS_XB), (float*)(ws + WS_SS)}; { int np = 2; asm volatile("" : "+s"(np)); for (int pass = 0; pass < np; ++pass) { if ((pass == 0) == ((bid & 1) != 0)) tail_splitk<2, 4>(lds, g.A, g.Bt, DFF, MM, 8, 0, 16, 0, E); else pg8::gemm_phase<EpiResid>(lds, g, S, E); } } }
        SEAM();
    }
    if (PM(9) && RUN()) { PHASE_LOCALS(); WAVE_LOCALS();
        const float* p_gf = INP(P, 27); const bf16_t* XBf = (const bf16_t*)(ws + WS_XB); const float* ss1 = (const float*)(ws + WS_SS);
        for (int row = bid * 8 + w; row < M; row += G * 8) {
            float* dst;
            if (row < MP) { const int b = row / TP, t = row % TP; if (t < 16) continue; dst = P.out + O_YP + ((size_t)b * 2048 + (t - 16)) * D; }
            else dst = P.out + O_YS + (size_t)(row - MP) * D;
            const float rs = rsqrtf(ss_total(ss1, row) * (1.f / 1024.f) + EPS);
#pragma unroll
            for (int j = 0; j < 4; ++j) { const u32x2 xw = *(const u32x2*)(XBf + (size_t)row * D + j * 256 + lane * 4); const f32x4 v = {bflo(xw.x), bfhi(xw.x), bflo(xw.y), bfhi(xw.y)}; const f32x4 gf = *(const f32x4*)(p_gf + j * 256 + lane * 4);
                *(f32x4*)(dst + j * 256 + lane * 4) = v * rs * gf; }
        }
    }
#undef RUN
#undef SEAM
}

extern "C" void kernel_launch(void* const* d_in, const int* in_sizes, int n_in, void* d_out, int out_size, void* d_ws, size_t ws_size, hipStream_t stream) {
    static int grid = 0;
    if (grid == 0) {
        int dev = 0, cus = 0, per_cu = 0;
        if (n_in != 28 || ws_size < WS_END) { fprintf(stderr, "kernel_launch: unexpected n_in %d / ws_size %zu (need %zu)\n", n_in, ws_size, (size_t)WS_END); grid = -1; return; }
        hipGetDevice(&dev);
        hipDeviceGetAttribute(&cus, hipDeviceAttributeMultiprocessorCount, dev);
        if (hipFuncSetAttribute((const void*)mega, hipFuncAttributeMaxDynamicSharedMemorySize, LDS_BYTES) != hipSuccess) { fprintf(stderr, "kernel_launch: hipFuncSetAttribute failed\n"); grid = -1; return; }
        if (hipOccupancyMaxActiveBlocksPerMultiprocessor(&per_cu, (const void*)mega, 512, LDS_BYTES) != hipSuccess || per_cu < 1) { fprintf(stderr, "kernel_launch: occupancy query gave %d\n", per_cu); per_cu = 1; }
        (void)hipGetLastError();
        grid = cus * per_cu;
    }
    if (grid < 0) return;
    if (hipMemsetAsync((char*)d_ws + WS_BAR, 0, 16384, stream) != hipSuccess) { fprintf(stderr, "kernel_launch: memset of the barrier words failed\n"); return; }
    Params p{};
    for (int i = 0; i < 28; ++i) p.in[i] = (const float*)d_in[i];
    p.out = (float*)d_out; p.ws = (unsigned char*)d_ws; p.ph_lo = 0; p.ph_hi = 1000;
    void* args[] = {&p};
    hipError_t e = hipLaunchCooperativeKernel((const void*)mega, dim3(grid), dim3(512), args, LDS_BYTES, stream);
    if (e != hipSuccess) fprintf(stderr, "cooperative launch failed: %s (grid %d)\n", hipGetErrorString(e), grid);
}
```
